# Optimizing an MI355X kernel written in HIP

```python
import jax, jax.numpy as jnp
from jax import lax
import numpy as np

D_MODEL = 1024
BATCH = 4
SEQ = 4096
DEPTH = 4

GRID_W = 64
CTX_LEN = 256
CHUNK = 128
A_GROUPS = 4
A_W = D_MODEL // 2
A_GROUP_DIM = A_W // A_GROUPS
B_HEAD_DIM = 64
B_W = D_MODEL // 2
B_HEADS = B_W // B_HEAD_DIM
WIN_H = 8
WIN_W = 16
MIX_IN = 2 * A_W + 3 * B_W
MIX_OUT = A_W + B_W
CONV_K = 31
CONV_W = D_MODEL
FFN = 4 * D_MODEL
N_EVEN = (DEPTH + 1) // 2
N_ODD = DEPTH // 2
EPS = 1e-6
NEG = -1e30

kernel_name = "hybrid_gmlp_natten_conformer_dit"


def rmsnorm(x, g):
    x32 = x.astype(jnp.float32)
    y = x32 * lax.rsqrt(jnp.mean(x32 * x32, axis=-1, keepdims=True) + EPS)
    return (y * g.astype(jnp.float32)).astype(x.dtype)


def layernorm(x, g, b=None):
    x32 = x.astype(jnp.float32)
    mu = jnp.mean(x32, axis=-1, keepdims=True)
    var = jnp.mean(jnp.square(x32 - mu), axis=-1, keepdims=True)
    y = (x32 - mu) * lax.rsqrt(var + EPS) * g.astype(jnp.float32)
    if b is not None:
        y = y + b.astype(jnp.float32)
    return y.astype(x.dtype)


def modulate(h, shift, scale):
    return h * (1 + scale) + shift


def split_heads(t):
    return t.reshape(*t.shape[:-1], B_HEADS, B_HEAD_DIM)


def spatial_gating(z, ln_v_g, w_sp, b_sp):
    u, g = jnp.split(jax.nn.gelu(z), 2, axis=-1)
    bsz, length, _ = g.shape
    g = g.reshape(bsz, length // CHUNK, CHUNK, A_GROUPS, A_GROUP_DIM)
    g = layernorm(g, ln_v_g.reshape(A_GROUPS, A_GROUP_DIM))
    s = jnp.einsum('gpq,bnqgc->bnpgc', w_sp, g) + b_sp.T[:, :, None]
    return u * s.reshape(bsz, length, A_W)


def neighborhood_attention(q, k, v, k_ctx, v_ctx, rpb):
    bsz, seq, nh, dh = q.shape
    rows_n = seq // GRID_W
    kh = min(WIN_H, rows_n)
    kw = WIN_W
    qg = q.reshape(bsz, rows_n, GRID_W, nh, dh)
    kg = k.reshape(bsz, rows_n, GRID_W, nh, dh)
    vg = v.reshape(bsz, rows_n, GRID_W, nh, dh)
    rows = jnp.arange(rows_n)
    row_idx = jnp.clip(rows - kh // 2, 0, rows_n - kh)[:, None] + jnp.arange(kh)
    k_band = kg[:, row_idx]
    v_band = vg[:, row_idx]
    cols = jnp.arange(GRID_W)
    col_start = jnp.clip(cols - kw // 2, 0, GRID_W - kw)
    col_mask = (cols[None, :] >= col_start[:, None]) & (cols[None, :] < col_start[:, None] + kw)
    dr = row_idx - rows[:, None] + WIN_H - 1
    dc = jnp.clip(cols[None, :] - cols[:, None] + WIN_W - 1, 0, 2 * WIN_W - 2)
    bias = rpb[:, dr[:, None, :, None], dc[None, :, None, :]].astype(jnp.float32)
    scale = dh ** -0.5
    s_loc = jnp.einsum('brqhd,brkwhd->bhrqkw', qg, k_band).astype(jnp.float32) * scale + bias[None]
    s_loc = jnp.where(col_mask[:, None, :], s_loc, NEG)
    s_ctx = jnp.einsum('brqhd,bchd->bhrqc', qg, k_ctx).astype(jnp.float32) * scale
    n_loc = kh * GRID_W
    s = jnp.concatenate([s_loc.reshape(bsz, nh, rows_n, GRID_W, n_loc), s_ctx], axis=-1)
    p = jax.nn.softmax(s, axis=-1).astype(v.dtype)
    p_loc = p[..., :n_loc].reshape(bsz, nh, rows_n, GRID_W, kh, GRID_W)
    p_ctx = p[..., n_loc:]
    out = (jnp.einsum('bhrqkw,brkwhd->brqhd', p_loc, v_band)
           + jnp.einsum('bhrqc,bchd->brqhd', p_ctx, v_ctx))
    return out.reshape(bsz, seq, nh * dh)


def context_attention(q, k, v):
    s = jnp.einsum('bqhd,bkhd->bhqk', q, k).astype(jnp.float32) * (q.shape[-1] ** -0.5)
    p = jax.nn.softmax(s, axis=-1).astype(v.dtype)
    out = jnp.einsum('bhqk,bkhd->bqhd', p, v)
    return out.reshape(*out.shape[:2], -1)


def even_mixer(h, hc, w_in, w_out, ln_v_g, w_sp, b_sp, rpb, ctx_out):
    cuts = [2 * A_W, 2 * A_W + B_W, 2 * A_W + 2 * B_W]
    if ctx_out:
        zc, qc, kc, vc = jnp.split(hc @ w_in, cuts, axis=-1)
    else:
        kc, vc = jnp.split(hc @ w_in[:, cuts[1]:], 2, axis=-1)
    kc, vc = split_heads(kc), split_heads(vc)
    z, q, k, v = jnp.split(h @ w_in, cuts, axis=-1)
    a = spatial_gating(z, ln_v_g, w_sp, b_sp)
    b = neighborhood_attention(split_heads(q), split_heads(k), split_heads(v), kc, vc, rpb)
    y = jnp.concatenate([a, b], axis=-1) @ w_out
    yc = None
    if ctx_out:
        ac = spatial_gating(zc, ln_v_g, w_sp, b_sp)
        bc = context_attention(split_heads(qc), kc, vc)
        yc = jnp.concatenate([ac, bc], axis=-1) @ w_out
    return y, yc


def conformer_conv(h, w_pw1, b_pw1, w_dw, b_dw, ln_g, ln_b, w_pw2, b_pw2):
    a, gate = jnp.split(h @ w_pw1 + b_pw1, 2, axis=-1)
    y = a * jax.nn.sigmoid(gate)
    y = lax.conv_general_dilated(y, w_dw[:, None, :], window_strides=(1,),
                                 padding=[(CONV_K // 2, CONV_K // 2)],
                                 dimension_numbers=('NWC', 'WIO', 'NWC'),
                                 feature_group_count=CONV_W) + b_dw
    y = jax.nn.silu(layernorm(y, ln_g, ln_b))
    return y @ w_pw2 + b_pw2


def sq_relu_mlp(h, w1, w2):
    return jnp.square(jax.nn.relu(h @ w1)) @ w2


def setup_inputs(seed: int = 0) -> dict:
    key = jax.random.key(seed)
    ks = jax.random.split(key, 24)
    f32 = jnp.float32
    nrm = lambda k, shape, s: jax.random.normal(k, shape, f32) * s
    D = D_MODEL
    return {
        "x": nrm(ks[0], (BATCH, SEQ, D), 1.0),
        "c": nrm(ks[1], (BATCH, D), 1.0),
        "ctx": nrm(ks[2], (BATCH, CTX_LEN, D), 1.0),
        "c_ctx": nrm(ks[3], (D,), 1.0),
        "w_mod": nrm(ks[4], (DEPTH, D, 6 * D), 0.5 * D ** -0.5),
        "b_mod": nrm(ks[5], (DEPTH, 6 * D), 0.02),
        "norm_g": 1.0 + nrm(ks[6], (DEPTH, 2, D), 0.05),
        "w_in": nrm(ks[7], (N_EVEN, D, MIX_IN), D ** -0.5),
        "w_out": nrm(ks[8], (N_EVEN, MIX_OUT, D), MIX_OUT ** -0.5),
        "ln_v_g": 1.0 + nrm(ks[9], (N_EVEN, A_W), 0.05),
        "w_sp": nrm(ks[10], (N_EVEN, A_GROUPS, CHUNK, CHUNK), CHUNK ** -0.5),
        "b_sp": 1.0 + nrm(ks[11], (N_EVEN, A_GROUPS, CHUNK), 0.1),
        "rpb": nrm(ks[12], (N_EVEN, B_HEADS, 2 * WIN_H - 1, 2 * WIN_W - 1), 0.1),
        "w_pw1": nrm(ks[13], (N_ODD, D, 2 * CONV_W), D ** -0.5),
        "b_pw1": nrm(ks[14], (N_ODD, 2 * CONV_W), 0.02),
        "w_dw": nrm(ks[15], (N_ODD, CONV_K, CONV_W), CONV_K ** -0.5),
        "b_dw": nrm(ks[16], (N_ODD, CONV_W), 0.02),
        "ln_c_g": 1.0 + nrm(ks[17], (N_ODD, CONV_W), 0.05),
        "ln_c_b": nrm(ks[18], (N_ODD, CONV_W), 0.02),
        "w_pw2": nrm(ks[19], (N_ODD, CONV_W, D), CONV_W ** -0.5),
        "b_pw2": nrm(ks[20], (N_ODD, D), 0.02),
        "w_ff1": nrm(ks[21], (DEPTH, D, FFN), D ** -0.5),
        "w_ff2": nrm(ks[22], (DEPTH, FFN, D), FFN ** -0.5),
        "final_g": 1.0 + nrm(ks[23], (D,), 0.05),
    }


def reference(x, c, ctx, c_ctx, w_mod, b_mod, norm_g, w_in, w_out, ln_v_g, w_sp, b_sp, rpb,
              w_pw1, b_pw1, w_dw, b_dw, ln_c_g, ln_c_b, w_pw2, b_pw2, w_ff1, w_ff2, final_g):
    last_reader = ((DEPTH - 1) // 2) * 2
    sc_c = jax.nn.silu(c)
    sc_ctx = jax.nn.silu(c_ctx)
    for l in range(DEPTH):
        m = (sc_c @ w_mod[l] + b_mod[l])[:, None, :]
        sh1, s1, g1, sh2, s2, g2 = jnp.split(m, 6, axis=-1)
        mc = sc_ctx @ w_mod[l] + b_mod[l]
        csh1, cs1, cg1, csh2, cs2, cg2 = jnp.split(mc, 6, axis=-1)
        ctx_out = l < last_reader
        h = modulate(rmsnorm(x, norm_g[l, 0]), sh1, s1)
        if l % 2 == 0:
            i = l // 2
            hc = modulate(rmsnorm(ctx, norm_g[l, 0]), csh1, cs1)
            y, yc = even_mixer(h, hc, w_in[i], w_out[i], ln_v_g[i], w_sp[i], b_sp[i], rpb[i], ctx_out)
        else:
            i = l // 2
            conv = lambda t: conformer_conv(t, w_pw1[i], b_pw1[i], w_dw[i], b_dw[i],
                                            ln_c_g[i], ln_c_b[i], w_pw2[i], b_pw2[i])
            y = conv(h)
            yc = conv(modulate(rmsnorm(ctx, norm_g[l, 0]), csh1, cs1)) if ctx_out else None
        x = x + g1 * y
        x = x + g2 * sq_relu_mlp(modulate(rmsnorm(x, norm_g[l, 1]), sh2, s2), w_ff1[l], w_ff2[l])
        if ctx_out:
            ctx = ctx + cg1 * yc
            ctx = ctx + cg2 * sq_relu_mlp(modulate(rmsnorm(ctx, norm_g[l, 1]), csh2, cs2), w_ff1[l], w_ff2[l])
    return rmsnorm(x, final_g)
```

```cpp
#include <hip/hip_runtime.h>
#include <hip/hip_cooperative_groups.h>
#include <cstdio>
#include <cstdint>
namespace cg = cooperative_groups;

namespace pg8 {
#define PG8_LAS __attribute__((address_space(3)))
typedef unsigned short bf16_t;
typedef short bf16x8 __attribute__((ext_vector_type(8)));
typedef float f32x4 __attribute__((ext_vector_type(4)));
typedef unsigned u32x4 __attribute__((ext_vector_type(4)));
constexpr int BM = 256, BK = 64, HALF = 128, HTB = HALF * BK * 2  , STAGE_BYTES = 8 * HTB, NXCD = 8, WGM = 8;

__host__ __device__ __forceinline__ int lds_byte(int r, int c) { const int st = (r >> 4) * 2 + (c >> 5), rr = r & 15, cc = c & 31, ob = rr * 64 + cc * 2; return st * 1024 + (ob ^ (((ob >> 9) & 1) << 5)); }
__host__ __device__ __forceinline__ void stage_rc(int b, int& R, int& C) { const int st = b / 1024, sb = b % 1024, swz = sb ^ (((sb >> 9) & 1) << 5); R = (st >> 1) * 16 + swz / 64; C = (st & 1) * 32 + (swz % 64) / 2; }
__host__ __device__ __forceinline__ int perm32(int rho) { const int n = rho >> 4, i = rho & 15; return 8 * (i >> 2) + 4 * n + (i & 3); }

__device__ __forceinline__ int tid_opaque() { int t = threadIdx.x; asm volatile("" : "+v"(t)); return t; }
struct Unit { int pm, pn, kind, kt0, knt; };
struct Gemm { const bf16_t* A; const bf16_t* Bt; int M, N, K; const bf16_t* A2; const bf16_t* Bt2; };

struct StaticOrder {
    int nM, nN, nwg, G, c, nM2, nN2, nwg2, nMs, nsplit, nws, ntf;
    __device__ void init(int M, int N, int K, int G_, int c_, int M2 = 0, int N2 = 0, int Ms = 0, int splits = 1) { nM = M / BM; nN = N / BM; nwg = nM * nN; G = G_; c = c_; nM2 = M2 / BM; nN2 = N2 / BM; nwg2 = nM2 * nN2;
        nMs = Ms / BM; nsplit = splits; nws = nMs * nN * splits; ntf = K / BK; }
    __device__ static void map(int wgid, int nwg_, int nM_, int nN_, Unit& u) {
        { const int q = nwg_ / NXCD, r = nwg_ % NXCD, xcd = wgid % NXCD, off = wgid / NXCD; wgid = (xcd < r ? xcd * (q + 1) : r * (q + 1) + (xcd - r) * q) + off; }
        const int nig = WGM * nN_, gid = wgid / nig, fm = gid * WGM, gsz = (nM_ - fm) < WGM ? (nM_ - fm) : WGM;
        u.pm = fm + ((wgid % nig) % gsz); u.pn = (wgid % nig) / gsz;
    }
    __device__ bool next(int i, Unit& u) const {
        const long L = (long)i * G + c; if (L >= nwg + nwg2 + nws) return false;
        u.kt0 = 0; u.knt = ntf;
        if (L < nwg) { map((int)L, nwg, nM, nN, u); u.kind = 0; }
        else if (L < nwg + nwg2) { const int e = (int)L - nwg; u.pm = e % nM2; u.pn = e / nM2; u.kind = 1; }
        else { const int e = (int)L - nwg - nwg2, part = e % nsplit, tile = e / nsplit; u.pm = nM + tile % nMs; u.pn = tile / nMs; u.kind = 2; u.knt = ntf / nsplit; u.kt0 = part * u.knt; }
        return true;
    }
    __device__ __forceinline__ void a_ready(const Unit&) const {}
    __device__ __forceinline__ void done(const Unit&) const {}
};

__device__ __forceinline__ unsigned cvt_pk_bf16(float lo, float hi) { unsigned r; asm volatile("v_cvt_pk_bf16_f32 %0, %1, %2" : "=v"(r) : "v"(lo), "v"(hi)); return r; }

template <class Epi, class Sched, bool ALIGN_EPI = false, bool SP2 = false>
__device__ __forceinline__ void gemm_phase(PG8_LAS unsigned char* lds, const Gemm g, const Sched& S, const Epi& E) {
    const int tid = tid_opaque(), wid = __builtin_amdgcn_readfirstlane(tid >> 6), lane = tid & 63, wr = wid >> 2, wc = wid & 3, fr = lane & 15, fq = lane >> 4;
    const int K = g.K, nt = K / BK;
    unsigned voffA[2], voffB[2];
#pragma unroll
    for (int i = 0; i < 2; ++i) { int R, C; stage_rc(tid * 16 + i * 8192, R, C); const int Rb = Epi::PERM ? ((R & ~31) + perm32(R & 31)) : R;
        voffA[i] = (unsigned)(R * K + C) * 2u; voffB[i] = (unsigned)(Rb * K + C) * 2u; }
    const size_t kstep = (size_t)(BK * 2);
    const size_t hstep = (size_t)HALF * K * 2;
    const size_t tstep = 2 * hstep;
    const unsigned ldsw = (unsigned)wid * 1024u;
    const int aoff = lds_byte(wr * 64 + fr, fq * 8), boff = lds_byte(wc * 32 + fr, fq * 8);
#define PG8_SA(b, h) (((b) * 2 + (h)) * HTB)
#define PG8_SB(b, h) ((4 + (b) * 2 + (h)) * HTB)
#define PG8_STAGE(bufoff, gbase, voff) do { _Pragma("unroll") for (int _i = 0; _i < 2; ++_i) \
        __builtin_amdgcn_global_load_lds((const unsigned*)((const char*)(gbase) + (voff)[_i]), (PG8_LAS unsigned*)(lds + (bufoff) + ldsw + _i * 8192), 16, 0, 0); } while (0)
#define PG8_LDA(dst, b, h) do { _Pragma("unroll") for (int m = 0; m < 4; ++m) _Pragma("unroll") for (int k = 0; k < 2; ++k) dst[m][k] = *(const PG8_LAS bf16x8*)(lds + PG8_SA(b, h) + aoff + m * 2048 + k * 1024); } while (0)
#define PG8_LDB(dst, b, h) do { _Pragma("unroll") for (int n = 0; n < 2; ++n) _Pragma("unroll") for (int k = 0; k < 2; ++k) dst[n][k] = *(const PG8_LAS bf16x8*)(lds + PG8_SB(b, h) + boff + n * 2048 + k * 1024); } while (0)
#define PG8_MMA(ai, bj, At, Bt) do { __builtin_amdgcn_s_setprio(1); _Pragma("unroll") for (int m = 0; m < 4; ++m) _Pragma("unroll") for (int n = 0; n < 2; ++n) _Pragma("unroll") for (int k = 0; k < 2; ++k) \
        acc[ai][bj][m][n] = __builtin_amdgcn_mfma_f32_16x16x32_bf16(Bt[n][k], At[m][k], acc[ai][bj][m][n], 0, 0, 0); __builtin_amdgcn_s_setprio(0); } while (0)
#define PG8_WAIT_V(n) asm volatile("s_waitcnt vmcnt(" #n ")" ::: "memory")
#define PG8_WAIT_L(n) asm volatile("s_waitcnt lgkmcnt(" #n ")" ::: "memory")
#define PG8_BAR __builtin_amdgcn_s_barrier()
#define PG8_SCHED __builtin_amdgcn_sched_barrier(0)
    Unit cur, nxt; int ui = 0;
    if (!S.next(0, cur)) return;
    f32x4 acc[2][2][4][2];
#pragma unroll
    for (int a = 0; a < 2; ++a)
#pragma unroll
        for (int b = 0; b < 2; ++b)
#pragma unroll
            for (int m = 0; m < 4; ++m)
#pragma unroll
                for (int n = 0; n < 2; ++n) acc[a][b][m][n] = (f32x4){0.f, 0.f, 0.f, 0.f};
    typename Epi::Pre pre; E.preload(pre, cur, wr, wc, fr, fq);
    if constexpr (Epi::ACC_INIT) E.init_acc(acc, cur, wr, wc, fr, fq, pre);
    bf16x8 At[4][2], B0[2][2], B1[2][2];
    const char* cA = (const char*)(cur.kind == 1 ? g.A2 : g.A) + (size_t)cur.pm * tstep + (size_t)cur.kt0 * kstep; const char* cB = (const char*)(cur.kind == 1 ? g.Bt2 : g.Bt) + (size_t)cur.pn * tstep + (size_t)cur.kt0 * kstep;
    S.a_ready(cur);
    if constexpr (SP2) {
        PG8_STAGE(PG8_SB(0, 0), cB, voffB); PG8_STAGE(PG8_SB(0, 1), cB + hstep, voffB); PG8_STAGE(PG8_SA(0, 0), cA, voffA); PG8_STAGE(PG8_SA(0, 1), cA + hstep, voffA);
        if (wr == 1) PG8_BAR;
        PG8_WAIT_V(2); PG8_BAR;
        PG8_STAGE(PG8_SB(1, 0), cB + kstep, voffB); PG8_STAGE(PG8_SA(1, 0), cA + kstep, voffA); PG8_STAGE(PG8_SB(1, 1), cB + hstep + kstep, voffB);
        PG8_WAIT_V(6); PG8_BAR;
    } else {
        PG8_STAGE(PG8_SB(0, 0), cB, voffB); PG8_STAGE(PG8_SA(0, 0), cA, voffA); PG8_STAGE(PG8_SB(0, 1), cB + hstep, voffB); PG8_STAGE(PG8_SA(0, 1), cA + hstep, voffA);
        if (wr == 1) PG8_BAR;
        PG8_WAIT_V(4); PG8_BAR;
        PG8_STAGE(PG8_SB(1, 0), cB + kstep, voffB); PG8_STAGE(PG8_SA(1, 0), cA + kstep, voffA); PG8_STAGE(PG8_SB(1, 1), cB + hstep + kstep, voffB);
        PG8_WAIT_V(6); PG8_BAR;
    }
    for (;;) {
        const bool has_next = S.next(ui + 1, nxt);
        const char* nA = has_next ? (const char*)(nxt.kind == 1 ? g.A2 : g.A) + (size_t)nxt.pm * tstep + (size_t)nxt.kt0 * kstep : cA; const char* nB = has_next ? (const char*)(nxt.kind == 1 ? g.Bt2 : g.Bt) + (size_t)nxt.pn * tstep + (size_t)nxt.kt0 * kstep : cB;
        const int cnt = cur.knt;
        for (int t = 0; t < cnt; t += 2) {
            const bool last = (t == cnt - 2);
            const char* a1 = cA + (size_t)(t + 1) * kstep;
            const char* a2 = last ? nA : cA + (size_t)(t + 2) * kstep; const char* b2 = last ? nB : cB + (size_t)(t + 2) * kstep;
            const char* a3 = a2 + kstep; const char* b3 = b2 + kstep;
            if (last && has_next) S.a_ready(nxt);
            if constexpr (SP2) {
            PG8_LDB(B0, 0, 0); PG8_LDB(B1, 0, 1); PG8_SCHED; PG8_LDA(At, 0, 0); PG8_STAGE(PG8_SA(1, 1), a1 + hstep, voffA);
            PG8_WAIT_V(8); PG8_WAIT_L(0); PG8_BAR; PG8_MMA(0, 0, At, B0); PG8_MMA(0, 1, At, B1); PG8_BAR; PG8_SCHED;
            PG8_LDA(At, 0, 1); PG8_STAGE(PG8_SB(0, 0), b2, voffB); PG8_STAGE(PG8_SB(0, 1), b2 + hstep, voffB); PG8_STAGE(PG8_SA(0, 0), a2, voffA);
            PG8_WAIT_V(8); PG8_WAIT_L(0); PG8_BAR; PG8_MMA(1, 0, At, B0); PG8_MMA(1, 1, At, B1); PG8_BAR; PG8_SCHED;
            PG8_LDB(B0, 1, 0); PG8_LDB(B1, 1, 1); PG8_SCHED; PG8_LDA(At, 1, 0); PG8_STAGE(PG8_SA(0, 1), a2 + hstep, voffA);
            PG8_WAIT_V(8); PG8_WAIT_L(0); PG8_BAR; PG8_MMA(0, 0, At, B0); PG8_MMA(0, 1, At, B1); PG8_BAR; PG8_SCHED;
            PG8_LDA(At, 1, 1); PG8_STAGE(PG8_SB(1, 0), b3, voffB); PG8_STAGE(PG8_SB(1, 1), b3 + hstep, voffB); PG8_STAGE(PG8_SA(1, 0), a3, voffA);
            PG8_WAIT_V(8); PG8_WAIT_L(0); PG8_BAR; PG8_MMA(1, 0, At, B0); PG8_MMA(1, 1, At, B1); PG8_BAR; PG8_SCHED;
            } else {
            PG8_LDB(B0, 0, 0); PG8_SCHED; PG8_LDA(At, 0, 0); PG8_STAGE(PG8_SA(1, 1), a1 + hstep, voffA);
            PG8_WAIT_L(8); PG8_BAR; PG8_WAIT_L(0); PG8_MMA(0, 0, At, B0); PG8_BAR; PG8_SCHED;
            PG8_LDB(B1, 0, 1); PG8_STAGE(PG8_SB(0, 0), b2, voffB);
            PG8_BAR; PG8_WAIT_L(0); PG8_MMA(0, 1, At, B1); PG8_BAR;
            PG8_LDA(At, 0, 1); PG8_STAGE(PG8_SA(0, 0), a2, voffA);
            PG8_BAR; PG8_WAIT_L(0); PG8_MMA(1, 0, At, B0); PG8_BAR; PG8_SCHED;
            PG8_STAGE(PG8_SB(0, 1), b2 + hstep, voffB);
            PG8_WAIT_V(6); PG8_BAR; PG8_MMA(1, 1, At, B1); PG8_BAR;
            PG8_LDB(B0, 1, 0); PG8_SCHED; PG8_LDA(At, 1, 0); PG8_STAGE(PG8_SA(0, 1), a2 + hstep, voffA);
            PG8_WAIT_L(8); PG8_BAR; PG8_WAIT_L(0); PG8_MMA(0, 0, At, B0); PG8_BAR; PG8_SCHED;
            PG8_LDB(B1, 1, 1); PG8_STAGE(PG8_SB(1, 0), b3, voffB);
            PG8_BAR; PG8_WAIT_L(0); PG8_MMA(0, 1, At, B1); PG8_BAR;
            PG8_LDA(At, 1, 1); PG8_STAGE(PG8_SA(1, 0), a3, voffA);
            PG8_BAR; PG8_WAIT_L(0); PG8_MMA(1, 0, At, B0); PG8_BAR; PG8_SCHED;
            PG8_STAGE(PG8_SB(1, 1), b3 + hstep, voffB);
            PG8_WAIT_V(6); PG8_BAR; PG8_MMA(1, 1, At, B1); PG8_BAR;
            }
        }
        if constexpr (ALIGN_EPI) { if (wr == 0) PG8_BAR; }
        if constexpr (!Epi::AFTER_DRAIN) { E(acc, cur, wr, wc, fr, fq, pre); S.done(cur); }
        if (!has_next) break;
#pragma unroll
        for (int a = 0; a < 2; ++a)
#pragma unroll
            for (int b = 0; b < 2; ++b)
#pragma unroll
                for (int m = 0; m < 4; ++m)
#pragma unroll
                    for (int n = 0; n < 2; ++n) acc[a][b][m][n] = (f32x4){0.f, 0.f, 0.f, 0.f};
        cur = nxt; cA = nA; cB = nB; ++ui;
        E.preload(pre, cur, wr, wc, fr, fq);
        if constexpr (Epi::ACC_INIT) E.init_acc(acc, cur, wr, wc, fr, fq, pre);
        if constexpr (ALIGN_EPI) { if (wr == 1) PG8_BAR; }
    }
    PG8_WAIT_V(0);
    if constexpr (!ALIGN_EPI) { if (wr == 0) PG8_BAR; }
    PG8_BAR;
    if constexpr (Epi::AFTER_DRAIN) { E.fused(acc, cur, wr, wc, fr, fq, lds, wid, lane); S.done(cur); }
#undef PG8_SA
#undef PG8_SB
#undef PG8_STAGE
#undef PG8_LDA
#undef PG8_LDB
#undef PG8_MMA
#undef PG8_WAIT_V
#undef PG8_WAIT_L
#undef PG8_BAR
#undef PG8_SCHED
}
}

typedef unsigned short bf16;
typedef float f32x4 __attribute__((ext_vector_type(4)));
typedef unsigned u32x4 __attribute__((ext_vector_type(4)));
typedef unsigned u32x2 __attribute__((ext_vector_type(2)));
typedef short bf16x8 __attribute__((ext_vector_type(8)));

constexpr int D = 1024, NB = 4, SEQ = 4096, ML = NB * SEQ, CL = 256, MC = NB * CL, MT = ML + MC, FF = 4096, DEPTH = 4;
constexpr int NTHR = 512;
constexpr float EPS = 1e-6f;
constexpr size_t MiB = 1u << 20;
constexpr size_t WS_MOD = 1 * MiB, WS_WIN = 2 * MiB, WS_WOUT = 12 * MiB, WS_WPW1 = 16 * MiB, WS_WPW2 = 24 * MiB, WS_WFF1 = 28 * MiB, WS_WFF2 = 60 * MiB;
constexpr size_t WS_X = 92 * MiB, WS_H = 160 * MiB, WS_R = 194 * MiB, WS_PART = 330 * MiB  , WS_SS = 362 * MiB  , WS_BIASW = 365 * MiB  , WS_END = 366 * MiB;
constexpr size_t R_ZG = 0, R_Q = 34 * MiB, R_K = 51 * MiB, R_VT = 68 * MiB, R_AB = 85 * MiB;
constexpr int LDS_BYTES = 147456;

__device__ __forceinline__ float bf2f(unsigned short b) { return __builtin_bit_cast(float, (unsigned)b << 16); }
__device__ __forceinline__ float bflo(unsigned u) { return __builtin_bit_cast(float, u << 16); }
__device__ __forceinline__ float bfhi(unsigned u) { return __builtin_bit_cast(float, u & 0xffff0000u); }
__device__ __forceinline__ unsigned pk2(float lo, float hi) { return pg8::cvt_pk_bf16(lo, hi); }
__device__ __forceinline__ float fexp(float x) { return __builtin_amdgcn_exp2f(x * 1.4426950408889634f); }
__device__ __forceinline__ float sigm(float x) { return __builtin_amdgcn_rcpf(1.f + fexp(-x)); }
__device__ __forceinline__ float gelu_tanh(float x) { const float y = 0.7978845608028654f * (x + 0.044715f * x * x * x); return x * sigm(2.f * y); }
__device__ __forceinline__ float wave_sum(float v) {
#pragma unroll
    for (int o = 1; o < 64; o <<= 1) v += __shfl_xor(v, o);
    return v;
}

__device__ __forceinline__ float rstd_of(float ss) { return __builtin_amdgcn_rsqf(ss * (1.0f / 1024.0f) + 1e-6f); }
__device__ __forceinline__ float ss_row(const float* ssp, int row) { const f32x4 p = *(const f32x4*)(ssp + (size_t)row * 4); return (p[0] + p[1]) + (p[2] + p[3]); }
struct EpiWin {
    static constexpr bool PERM = true, AFTER_DRAIN = false, ACC_INIT = true;
    bf16 *ZG, *Q, *K, *VT; const float* ss; const float* bw  ;
    struct Pre { float v[16]; };
    __device__ __forceinline__ void preload(Pre& p, const pg8::Unit& u, int wr, int wc, int fr, int fq) const {
        if (u.kind) { const int col0 = u.pn * 256 + wc * 32 + 8 * fq;
#pragma unroll
            for (int j = 0; j < 16; ++j) p.v[j] = ss_row(ss, col0 + (j >> 3) * 128 + (j & 7)); }
        else { const int row0 = u.pm * 256 + wr * 64 + fr;
#pragma unroll
            for (int j = 0; j < 8; ++j) p.v[j] = ss_row(ss, row0 + (j >> 2) * 128 + (j & 3) * 16);
#pragma unroll
            for (int j = 8; j < 16; ++j) p.v[j] = 0.f; }
    }
    __device__ __forceinline__ void init_acc(f32x4 (&acc)[2][2][4][2], const pg8::Unit& u, int wr, int wc, int fr, int fq, const Pre& p) const {
        if (u.kind) {
            const int row0 = u.pm * 256 + wr * 64 + fr, bi = u.pn < (ML / 256) ? u.pn / (SEQ / 256) : 4;
            f32x4 ir[2][2];
#pragma unroll
            for (int bj = 0; bj < 2; ++bj)
#pragma unroll
                for (int n = 0; n < 2; ++n)
#pragma unroll
                    for (int e = 0; e < 4; ++e) ir[bj][n][e] = __builtin_amdgcn_sqrtf(p.v[bj * 8 + n * 4 + e] * (1.0f / 1024.0f) + 1e-6f);
#pragma unroll
            for (int ai = 0; ai < 2; ++ai)
#pragma unroll
                for (int m = 0; m < 4; ++m) { const float bb = bw[bi * 4096 + 2048 + row0 + ai * 128 + m * 16];
#pragma unroll
                    for (int bj = 0; bj < 2; ++bj)
#pragma unroll
                        for (int n = 0; n < 2; ++n) acc[ai][bj][m][n] = ir[bj][n] * bb; }
        } else {
            const int col0 = u.pn * 256 + wc * 32 + 8 * fq, bi = u.pm < (ML / 256) ? u.pm / (SEQ / 256) : 4;
            float ir[8];
#pragma unroll
            for (int j = 0; j < 8; ++j) ir[j] = __builtin_amdgcn_sqrtf(p.v[j] * (1.0f / 1024.0f) + 1e-6f);
#pragma unroll
            for (int bj = 0; bj < 2; ++bj)
#pragma unroll
                for (int n = 0; n < 2; ++n) { const f32x4 bsv = *(const f32x4*)(bw + bi * 4096 + col0 + bj * 128 + 4 * n);
#pragma unroll
                    for (int ai = 0; ai < 2; ++ai)
#pragma unroll
                        for (int m = 0; m < 4; ++m) acc[ai][bj][m][n] = bsv * ir[ai * 4 + m]; }
        }
    }
    __device__ __forceinline__ void operator()(const f32x4 (&acc)[2][2][4][2], const pg8::Unit& u, int wr, int wc, int fr, int fq, const Pre& p) const {
        const int row0 = u.pm * 256 + wr * 64 + fr; const int col0 = u.pn * 256 + wc * 32 + 8 * fq; int cb = col0;
        if (u.kind) {
            f32x4 rs[2][2];
#pragma unroll
            for (int bj = 0; bj < 2; ++bj)
#pragma unroll
                for (int n = 0; n < 2; ++n)
#pragma unroll
                    for (int e = 0; e < 4; ++e) rs[bj][n][e] = rstd_of(p.v[bj * 8 + n * 4 + e]);
#pragma unroll
            for (int ai = 0; ai < 2; ++ai)
#pragma unroll
                for (int m = 0; m < 4; ++m) { const int row = row0 + ai * 128 + m * 16; bf16* rowp = VT + (size_t)row * MT + cb;
#pragma unroll
                    for (int bj = 0; bj < 2; ++bj) { const f32x4 v0 = acc[ai][bj][m][0] * rs[bj][0], v1 = acc[ai][bj][m][1] * rs[bj][1];
                        u32x4 w; w.x = pk2(v0[0], v0[1]); w.y = pk2(v0[2], v0[3]); w.z = pk2(v1[0], v1[1]); w.w = pk2(v1[2], v1[3]);
                        *(u32x4*)(rowp + bj * 128) = w; } }
            return;
        }
        bf16* base; int ld; bool act = false;
        if (u.pn < 4) { base = ZG; ld = 1024; act = true; }
        else if (u.pn < 6) { base = Q; ld = 512; cb -= 1024; }
        else { base = K; ld = 512; cb -= 1536; }
#pragma unroll
        for (int ai = 0; ai < 2; ++ai)
#pragma unroll
            for (int m = 0; m < 4; ++m) { const int row = row0 + ai * 128 + m * 16; const float rs = rstd_of(p.v[ai * 4 + m]); bf16* rowp = base + (size_t)row * ld + cb;
#pragma unroll
                for (int bj = 0; bj < 2; ++bj) { f32x4 v0 = acc[ai][bj][m][0] * rs, v1 = acc[ai][bj][m][1] * rs;
                    if (act) {
#pragma unroll
                        for (int e = 0; e < 4; ++e) { v0[e] = gelu_tanh(v0[e]); v1[e] = gelu_tanh(v1[e]); } }
                    u32x4 w; w.x = pk2(v0[0], v0[1]); w.y = pk2(v0[2], v0[3]); w.z = pk2(v1[0], v1[1]); w.w = pk2(v1[2], v1[3]);
                    *(u32x4*)(rowp + bj * 128) = w; } }
    }
};
struct EpiGlu {
    static constexpr bool PERM = true, AFTER_DRAIN = false, ACC_INIT = true;
    bf16* O; const float* b1; const float* ss; const float* bw;
    struct Pre { float ssv[2][4]; };
    __device__ __forceinline__ void preload(Pre& p, const pg8::Unit& u, int wr, int wc, int fr, int fq) const {
        const int row0 = u.pm * 256 + wr * 64 + fr;
#pragma unroll
        for (int ai = 0; ai < 2; ++ai)
#pragma unroll
            for (int m = 0; m < 4; ++m) p.ssv[ai][m] = ss_row(ss, row0 + ai * 128 + m * 16);
    }
    __device__ __forceinline__ void init_acc(f32x4 (&acc)[2][2][4][2], const pg8::Unit& u, int wr, int wc, int fr, int fq, const Pre& p) const {
        const int ch0 = u.pn * 128 + wc * 32 + 8 * fq, bi = u.pm < (ML / 256) ? u.pm / (SEQ / 256) : 4; const float* bwb = bw + bi * 4096;
        float ir[2][4];
#pragma unroll
        for (int ai = 0; ai < 2; ++ai)
#pragma unroll
            for (int m = 0; m < 4; ++m) ir[ai][m] = __builtin_amdgcn_sqrtf(p.ssv[ai][m] * (1.0f / 1024.0f) + 1e-6f);
#pragma unroll
        for (int bj = 0; bj < 2; ++bj)
#pragma unroll
            for (int n = 0; n < 2; ++n) { const int c = bj * 1024 + ch0 + 4 * n; const f32x4 bsv = *(const f32x4*)(b1 + c) + *(const f32x4*)(bwb + c);
#pragma unroll
                for (int ai = 0; ai < 2; ++ai)
#pragma unroll
                    for (int m = 0; m < 4; ++m) acc[ai][bj][m][n] = bsv * ir[ai][m]; }
    }
    __device__ __forceinline__ void operator()(const f32x4 (&acc)[2][2][4][2], const pg8::Unit& u, int wr, int wc, int fr, int fq, const Pre& p) const {
        const int row0 = u.pm * 256 + wr * 64 + fr, ch0 = u.pn * 128 + wc * 32 + 8 * fq;
#pragma unroll
        for (int ai = 0; ai < 2; ++ai)
#pragma unroll
            for (int m = 0; m < 4; ++m) { const int row = row0 + ai * 128 + m * 16; const float rs = rstd_of(p.ssv[ai][m]);
                f32x4 a0 = acc[ai][0][m][0] * rs, a1 = acc[ai][0][m][1] * rs, g0 = acc[ai][1][m][0] * rs, g1 = acc[ai][1][m][1] * rs;
#pragma unroll
                for (int e = 0; e < 4; ++e) { a0[e] *= sigm(g0[e]); a1[e] *= sigm(g1[e]); }
                u32x4 w; w.x = pk2(a0[0], a0[1]); w.y = pk2(a0[2], a0[3]); w.z = pk2(a1[0], a1[1]); w.w = pk2(a1[2], a1[3]);
                *(u32x4*)(O + (size_t)row * 1024 + ch0) = w; }
    }
};
struct EpiFF1 {
    static constexpr bool PERM = true, AFTER_DRAIN = false, ACC_INIT = true;
    bf16* O; const float* ss; const float* bw;
    struct Pre { float ssv[2][4]; };
    __device__ __forceinline__ void preload(Pre& p, const pg8::Unit& u, int wr, int wc, int fr, int fq) const {
        const int row0 = u.pm * 256 + wr * 64 + fr;
#pragma unroll
        for (int ai = 0; ai < 2; ++ai)
#pragma unroll
            for (int m = 0; m < 4; ++m) p.ssv[ai][m] = ss_row(ss, row0 + ai * 128 + m * 16);
    }
    __device__ __forceinline__ void init_acc(f32x4 (&acc)[2][2][4][2], const pg8::Unit& u, int wr, int wc, int fr, int fq, const Pre& p) const {
        const int col0 = u.pn * 256 + wc * 32 + 8 * fq, bi = u.pm < (ML / 256) ? u.pm / (SEQ / 256) : 4;
        float ir[2][4];
#pragma unroll
        for (int ai = 0; ai < 2; ++ai)
#pragma unroll
            for (int m = 0; m < 4; ++m) ir[ai][m] = __builtin_amdgcn_sqrtf(p.ssv[ai][m] * (1.0f / 1024.0f) + 1e-6f);
#pragma unroll
        for (int bj = 0; bj < 2; ++bj)
#pragma unroll
            for (int n = 0; n < 2; ++n) { const f32x4 bsv = *(const f32x4*)(bw + bi * 4096 + col0 + bj * 128 + 4 * n);
#pragma unroll
                for (int ai = 0; ai < 2; ++ai)
#pragma unroll
                    for (int m = 0; m < 4; ++m) acc[ai][bj][m][n] = bsv * ir[ai][m]; }
    }
    __device__ __forceinline__ void operator()(const f32x4 (&acc)[2][2][4][2], const pg8::Unit& u, int wr, int wc, int fr, int fq, const Pre& p) const {
        const int row0 = u.pm * 256 + wr * 64 + fr, col0 = u.pn * 256 + wc * 32 + 8 * fq;
#pragma unroll
        for (int ai = 0; ai < 2; ++ai)
#pragma unroll
            for (int m = 0; m < 4; ++m) { const int row = row0 + ai * 128 + m * 16; const float rs = rstd_of(p.ssv[ai][m]); bf16* rowp = O + (size_t)row * FF + col0;
#pragma unroll
                for (int bj = 0; bj < 2; ++bj) { f32x4 v0 = acc[ai][bj][m][0] * rs, v1 = acc[ai][bj][m][1] * rs;
#pragma unroll
                    for (int e = 0; e < 4; ++e) { const float r0 = fmaxf(v0[e], 0.f), r1 = fmaxf(v1[e], 0.f); v0[e] = r0 * r0; v1[e] = r1 * r1; }
                    u32x4 w; w.x = pk2(v0[0], v0[1]); w.y = pk2(v0[2], v0[3]); w.z = pk2(v1[0], v1[1]); w.w = pk2(v1[2], v1[3]);
                    *(u32x4*)(rowp + bj * 128) = w; } }
    }
};
template <bool BIAS, bool LAST> struct EpiRes {
    static constexpr bool PERM = true, AFTER_DRAIN = false, ACC_INIT = BIAS;
    struct Pre {}; __device__ __forceinline__ void preload(Pre&, const pg8::Unit&, int, int, int, int) const {}
    __device__ __forceinline__ void init_acc(f32x4 (&acc)[2][2][4][2], const pg8::Unit& u, int, int wc, int, int fq, const Pre&) const {
        if (u.kt0 != 0) return;
        const int col0 = u.pn * 256 + wc * 32 + 8 * fq;
#pragma unroll
        for (int bj = 0; bj < 2; ++bj)
#pragma unroll
            for (int n = 0; n < 2; ++n) { const f32x4 bsv = *(const f32x4*)(bias + col0 + bj * 128 + 4 * n);
#pragma unroll
                for (int ai = 0; ai < 2; ++ai)
#pragma unroll
                    for (int m = 0; m < 4; ++m) acc[ai][bj][m][n] = bsv; }
    }
    bf16* HX; const float* gp; const float* scp  ; const float* gn; const float* scn  ;
    const float* gate  ; const float* bias; float* part; float* SSn  ; float* outf; float* lsq  ;
    __device__ __forceinline__ void operator()(const f32x4 (&acc)[2][2][4][2], const pg8::Unit& u, int wr, int wc, int fr, int fq, const Pre&) const {
        const int row0 = u.pm * 256 + wr * 64 + fr, col0 = u.pn * 256 + wc * 32 + 8 * fq;
        const int bi = u.pm < (ML / 256) ? u.pm / (SEQ / 256) : 4;
        if (u.kind == 2) {
#pragma unroll
            for (int bj = 0; bj < 2; ++bj)
#pragma unroll
                for (int n = 0; n < 2; ++n) { const int c = col0 + bj * 128 + 4 * n; const f32x4 gt = *(const f32x4*)(gate + (size_t)bi * 6144 + c);
                    #pragma unroll
                    for (int ai = 0; ai < 2; ++ai)
#pragma unroll
                        for (int m = 0; m < 4; ++m) { const int row = row0 + ai * 128 + m * 16;
                            *(f32x4*)(part + ((size_t)(u.kt0 / u.knt) * MC + (row - ML)) * D + c) = gt * acc[ai][bj][m][n]; } }
            return;
        }
        f32x4 gt[2][2], igp[2][2], gm[2][2];
#pragma unroll
        for (int bj = 0; bj < 2; ++bj)
#pragma unroll
            for (int n = 0; n < 2; ++n) { const int c = col0 + bj * 128 + 4 * n; gt[bj][n] = *(const f32x4*)(gate + (size_t)bi * 6144 + c);
                const f32x4 g0 = *(const f32x4*)(gp + c) * (*(const f32x4*)(scp + (size_t)bi * 6144 + c) + 1.0f);
                igp[bj][n] = (f32x4){__builtin_amdgcn_rcpf(g0[0]), __builtin_amdgcn_rcpf(g0[1]), __builtin_amdgcn_rcpf(g0[2]), __builtin_amdgcn_rcpf(g0[3])};
                if (LAST) gm[bj][n] = (f32x4){1.f, 1.f, 1.f, 1.f}; else gm[bj][n] = *(const f32x4*)(gn + c) * (*(const f32x4*)(scn + (size_t)bi * 6144 + c) + 1.0f); }
        u32x4 rbuf[1][2];
#define ERES_LOAD(slot, idx) do { const bf16* rp_ = HX + (size_t)(row0 + ((idx) >> 2) * 128 + ((idx) & 3) * 16) * D + col0; rbuf[slot][0] = *(const u32x4*)rp_; rbuf[slot][1] = *(const u32x4*)(rp_ + 128); } while (0)
        ERES_LOAD(0, 0);
#pragma unroll
        for (int idx = 0; idx < 8; ++idx) { const int ai = idx >> 2, m = idx & 3, row = row0 + ai * 128 + m * 16; float sq = 0.f;
            if (idx > 0) ERES_LOAD(0, idx);
#pragma unroll
            for (int bj = 0; bj < 2; ++bj) { const u32x4 w = rbuf[0][bj]; const int c = col0 + bj * 128;
                const f32x4 xn0 = (f32x4){bflo(w.x), bfhi(w.x), bflo(w.y), bfhi(w.y)} * igp[bj][0] + gt[bj][0] * acc[ai][bj][m][0];
                const f32x4 xn1 = (f32x4){bflo(w.z), bfhi(w.z), bflo(w.w), bfhi(w.w)} * igp[bj][1] + gt[bj][1] * acc[ai][bj][m][1];
                sq += (xn0[0] * xn0[0] + xn0[1] * xn0[1]) + (xn0[2] * xn0[2] + xn0[3] * xn0[3]) + (xn1[0] * xn1[0] + xn1[1] * xn1[1]) + (xn1[2] * xn1[2] + xn1[3] * xn1[3]);
                { const f32x4 y0 = xn0 * gm[bj][0], y1 = xn1 * gm[bj][1];
                    u32x4 o; o.x = pk2(y0[0], y0[1]); o.y = pk2(y0[2], y0[3]); o.z = pk2(y1[0], y1[1]); o.w = pk2(y1[2], y1[3]);
                    *(u32x4*)(HX + (size_t)row * D + c) = o; } }
            sq += __shfl_xor(sq, 16); sq += __shfl_xor(sq, 32);
            if (fq == 0) lsq[(ai * 128 + wr * 64 + m * 16 + fr) * 4 + wc] = sq; }
#undef ERES_LOAD
        asm volatile("s_waitcnt lgkmcnt(0)" ::: "memory"); __builtin_amdgcn_s_barrier(); asm volatile("" ::: "memory");
        { const int t = wr * 256 + wc * 64 + fq * 16 + fr;
          if (t < 256) { const f32x4 p4 = *(const f32x4*)(lsq + t * 4); SSn[(size_t)(u.pm * 256 + t) * 4 + u.pn] = (p4[0] + p4[1]) + (p4[2] + p4[3]); } }
    }
};

__device__ __forceinline__ void transpose_item(const float* W, int K, int N, bf16* WT, bool pw1perm, float* scr, int item, int lane) {
    const int nblk = N / 32, kb = item / nblk, nb = item % nblk, k0 = 64 * kb, n0 = 32 * nb;
    int nbase = n0;
    if (pw1perm) { nbase = (n0 < 1024) ? 256 * (n0 / 128) + (n0 % 128) : 256 * ((n0 - 1024) / 128) + 128 + ((n0 - 1024) % 128); }
#pragma unroll 8
    for (int i = 0; i < 32; ++i) { const int kk = 2 * i + (lane >> 5); scr[kk * 33 + (lane & 31)] = W[(size_t)(k0 + kk) * N + n0 + (lane & 31)]; }
    __builtin_amdgcn_s_waitcnt(0xc07f); asm volatile("s_waitcnt lgkmcnt(0)" ::: "memory");
    const int c = lane & 7;
#pragma unroll
    for (int j = 0; j < 4; ++j) { const int n = (lane >> 3) + 8 * j; const float* s = scr + (8 * c) * 33 + n;
        u32x4 o; o.x = pk2(s[0 * 33], s[1 * 33]); o.y = pk2(s[2 * 33], s[3 * 33]); o.z = pk2(s[4 * 33], s[5 * 33]); o.w = pk2(s[6 * 33], s[7 * 33]);
        *(u32x4*)(WT + (size_t)(nbase + n) * K + k0 + 8 * c) = o; }
    asm volatile("s_waitcnt lgkmcnt(0)" ::: "memory");
}

__device__ __forceinline__ void gemv5_item(const float* vec, float* red, const float* W, int ldw, int n0, float* out, int ostride, const float* addb, int tid) {
    const int cq = tid & 15, ks = tid >> 4;
    const float* Wp = W + n0 + 4 * cq;
    f32x4 acc[5];
#pragma unroll
    for (int r = 0; r < 5; ++r) acc[r] = (f32x4){0.f, 0.f, 0.f, 0.f};
#pragma unroll 4
    for (int kk = 0; kk < 32; ++kk) { const int k = ks * 32 + kk; const f32x4 w = *(const f32x4*)(Wp + (size_t)k * ldw);
#pragma unroll
        for (int r = 0; r < 5; ++r) acc[r] += w * vec[r * 1024 + k]; }
#pragma unroll
    for (int r = 0; r < 5; ++r) *(f32x4*)(red + (ks * 5 + r) * 64 + 4 * cq) = acc[r];
    __syncthreads();
    if (tid < 320) { const int r = tid >> 6, n = tid & 63; float s = 0.f;
        for (int k2 = 0; k2 < 32; ++k2) s += red[(k2 * 5 + r) * 64 + n];
        out[(size_t)r * ostride + n0 + n] = s + (addb ? addb[n0 + n] : 0.f); }
    __syncthreads();
}
__device__ __forceinline__ void p0a_phase(int G, const float* const* in, unsigned char* ws, unsigned char* lds) {
    const int tid = pg8::tid_opaque();
    float* sl = (float*)(lds + 72 * 1024);
    float* red = (float*)(lds + 92 * 1024);
    const float* cin = in[1]; const float* cctx = in[3];
    float* MOD = (float*)(ws + WS_MOD);
    for (int e = tid; e < 5 * 1024; e += NTHR) { const int r = e >> 10, k = e & 1023; const float v = r < 4 ? cin[r * 1024 + k] : cctx[k]; sl[e] = v * sigm(v); }
    __syncthreads();
    for (int item = blockIdx.x; item < 4 * 96; item += G) { const int l = item / 96, n0 = (item % 96) * 64;
        gemv5_item(sl, red, in[4] + (size_t)l * 1024 * 6144, 6144, n0, MOD + (size_t)l * 5 * 6144, 6144, in[5] + l * 6144, tid); }
}
__device__ __forceinline__ void prep_rows(int G, int row_lo, int row_hi, const float* src_lat, const float* src_ctx, const float* part, int nparts, float* Xctx,
                                          const float* g, const float* sc  , bf16* XB, float* SS) {
    const int tid = pg8::tid_opaque(), lane = tid & 63, gw = blockIdx.x * 8 + __builtin_amdgcn_readfirstlane(tid >> 6), NGW = G * 8;
    for (int row = row_lo + gw; row < row_hi; row += NGW) {
        const float* xr = row < ML ? src_lat + (size_t)row * D : src_ctx + (size_t)(row - ML) * D;
        const int bi = row < ML ? row / SEQ : 4;
        f32x4 v[4]; float ss = 0.f;
#pragma unroll
        for (int j = 0; j < 4; ++j) v[j] = *(const f32x4*)(xr + 256 * j + 4 * lane);
        if (row >= ML && nparts > 0) {
#pragma unroll 1
            for (int p = 0; p < nparts; ++p) { const float* pr = part + ((size_t)p * MC + (row - ML)) * D;
#pragma unroll
                for (int j = 0; j < 4; ++j) v[j] += *(const f32x4*)(pr + 256 * j + 4 * lane); }
#pragma unroll
            for (int j = 0; j < 4; ++j) *(f32x4*)(Xctx + (size_t)(row - ML) * D + 256 * j + 4 * lane) = v[j];
        }
#pragma unroll
        for (int j = 0; j < 4; ++j) ss += (v[j][0] * v[j][0] + v[j][1] * v[j][1]) + (v[j][2] * v[j][2] + v[j][3] * v[j][3]);
        ss = wave_sum(ss);
        if (lane == 0) *(f32x4*)(SS + (size_t)row * 4) = (f32x4){ss, 0.f, 0.f, 0.f};
        const float* scb = sc + (size_t)bi * 6144;
#pragma unroll
        for (int j = 0; j < 4; ++j) { const int c = 256 * j + 4 * lane;
            const f32x4 y = v[j] * *(const f32x4*)(g + c) * (*(const f32x4*)(scb + c) + 1.0f);
            u32x2 w; w.x = pk2(y[0], y[1]); w.y = pk2(y[2], y[3]);
            *(u32x2*)(XB + (size_t)row * D + c) = w; }
    }
}
__device__ __forceinline__ void fold_rows(int G, bf16* HX, const float* part, int nparts, const float* gp, const float* scp, const float* gn, const float* scn, float* SS) {
    const int tid = pg8::tid_opaque(), lane = tid & 63, gw = blockIdx.x * 8 + __builtin_amdgcn_readfirstlane(tid >> 6), NGW = G * 8;
    for (int row = ML + gw; row < MT; row += NGW) {
        f32x4 v[4]; float ss = 0.f;
#pragma unroll
        for (int j = 0; j < 4; ++j) { const int c = 256 * j + 4 * lane; const u32x2 w = *(const u32x2*)(HX + (size_t)row * D + c);
            const f32x4 g0 = *(const f32x4*)(gp + c) * (*(const f32x4*)(scp + (size_t)4 * 6144 + c) + 1.0f);
            v[j] = (f32x4){bflo(w.x) / g0[0], bfhi(w.x) / g0[1], bflo(w.y) / g0[2], bfhi(w.y) / g0[3]}; }
        f32x4 pv[8][4];
#pragma unroll
        for (int p = 0; p < 8; ++p) if (p < nparts) { const float* pr = part + ((size_t)p * MC + (row - ML)) * D;
#pragma unroll
            for (int j = 0; j < 4; ++j) pv[p][j] = *(const f32x4*)(pr + 256 * j + 4 * lane); }
#pragma unroll
        for (int p = 0; p < 8; ++p) if (p < nparts) {
#pragma unroll
            for (int j = 0; j < 4; ++j) v[j] += pv[p][j]; }
#pragma unroll
        for (int j = 0; j < 4; ++j) ss += (v[j][0] * v[j][0] + v[j][1] * v[j][1]) + (v[j][2] * v[j][2] + v[j][3] * v[j][3]);
        ss = wave_sum(ss);
        if (lane == 0) *(f32x4*)(SS + (size_t)row * 4) = (f32x4){ss, 0.f, 0.f, 0.f};
#pragma unroll
        for (int j = 0; j < 4; ++j) { const int c = 256 * j + 4 * lane;
            const f32x4 y = v[j] * *(const f32x4*)(gn + c) * (*(const f32x4*)(scn + (size_t)4 * 6144 + c) + 1.0f);
            u32x2 w; w.x = pk2(y[0], y[1]); w.y = pk2(y[2], y[3]);
            *(u32x2*)(HX + (size_t)row * D + c) = w; }
    }
}
__device__ __forceinline__ void p0b_phase(int G, const float* const* in, unsigned char* ws, unsigned char* lds) {
    const int tid = pg8::tid_opaque(), lane = tid & 63, wave = __builtin_amdgcn_readfirstlane(tid >> 6);
    float* sl = (float*)(lds + 72 * 1024);
    float* red = (float*)(lds + 92 * 1024);
    const float* MOD = (const float*)(ws + WS_MOD); float* BIASW = (float*)(ws + WS_BIASW);
    for (int item = blockIdx.x; item < 400; item += G) {
        int s, nb;
        if (item < 40) { s = 0; nb = item; } else if (item < 104) { s = 1; nb = item - 40; } else if (item < 136) { s = 2; nb = item - 104; } else if (item < 200) { s = 3; nb = item - 136; }
        else if (item < 240) { s = 4; nb = item - 200; } else if (item < 304) { s = 5; nb = item - 240; } else if (item < 336) { s = 6; nb = item - 304; } else { s = 7; nb = item - 336; }
        const int l = s >> 1; const float* W; int ldw;
        if (s & 1) { W = in[21] + (size_t)l * D * FF; ldw = FF; } else if ((l & 1) == 0) { W = in[7] + (size_t)(l >> 1) * D * 2560; ldw = 2560; } else { W = in[13] + (size_t)(l >> 1) * D * 2048; ldw = 2048; }
        const float* shp = MOD + (size_t)l * 5 * 6144 + ((s & 1) ? 3072 : 0);
        for (int e = tid; e < 5 * 1024; e += NTHR) sl[e] = shp[(size_t)(e >> 10) * 6144 + (e & 1023)];
        __syncthreads();
        gemv5_item(sl, red, W, ldw, nb * 64, BIASW + (size_t)s * 5 * 4096, 4096, nullptr, tid);
    }
    float* scr = (float*)(lds + wave * 8704);
    const int gw = blockIdx.x * 8 + wave, NGW = G * 8;
    bf16* Win_t = (bf16*)(ws + WS_WIN); bf16* Wout_t = (bf16*)(ws + WS_WOUT); bf16* Wpw1_t = (bf16*)(ws + WS_WPW1); bf16* Wpw2_t = (bf16*)(ws + WS_WPW2);
    bf16* Wff1_t = (bf16*)(ws + WS_WFF1); bf16* Wff2_t = (bf16*)(ws + WS_WFF2);
    constexpr int NITEMS = 8192 + 8192 + 2560 + 1024 + 2048 + 1024;
    for (int it = gw; it < NITEMS; it += NGW) {
        int r = it;
        if (r < 8192) { const int l = r / 2048; transpose_item(in[21] + (size_t)l * D * FF, D, FF, Wff1_t + (size_t)l * FF * D, false, scr, r % 2048, lane); continue; } r -= 8192;
        if (r < 8192) { const int l = r / 2048; transpose_item(in[22] + (size_t)l * FF * D, FF, D, Wff2_t + (size_t)l * D * FF, false, scr, r % 2048, lane); continue; } r -= 8192;
        if (r < 2560) { const int i = r / 1280; transpose_item(in[7] + (size_t)i * D * 2560, D, 2560, Win_t + (size_t)i * 2560 * D, false, scr, r % 1280, lane); continue; } r -= 2560;
        if (r < 1024) { const int i = r / 512; transpose_item(in[8] + (size_t)i * D * D, D, D, Wout_t + (size_t)i * D * D, false, scr, r % 512, lane); continue; } r -= 1024;
        if (r < 2048) { const int i = r / 1024; transpose_item(in[13] + (size_t)i * D * 2048, D, 2048, Wpw1_t + (size_t)i * 2048 * D, true, scr, r % 1024, lane); continue; } r -= 2048;
        { const int i = r / 512; transpose_item(in[19] + (size_t)i * D * D, D, D, Wpw2_t + (size_t)i * D * D, false, scr, r % 512, lane); }
    }
    prep_rows(G, 0, MT, in[0], in[2], nullptr, 0, nullptr, in[6], MOD + 1024, (bf16*)(ws + WS_H), (float*)(ws + WS_SS));
}
__device__ __forceinline__ void final_phase(int G, const bf16* HX, const float* SS, const float* g, float* out) {
    const int tid = pg8::tid_opaque(), lane = tid & 63, gw = blockIdx.x * 8 + __builtin_amdgcn_readfirstlane(tid >> 6), NGW = G * 8;
    for (int row = gw; row < ML; row += NGW) {
        const bf16* xr = HX + (size_t)row * D; const float rstd = rstd_of(ss_row(SS, row));
#pragma unroll
        for (int j = 0; j < 4; ++j) { const int c = 256 * j + 4 * lane; const u32x2 w = *(const u32x2*)(xr + c);
            *(f32x4*)(out + (size_t)row * D + c) = (f32x4){bflo(w.x), bfhi(w.x), bflo(w.y), bfhi(w.y)} * rstd * *(const f32x4*)(g + c); }
    }
}

__device__ __forceinline__ void gating_phase(int G, int nchunks, const bf16* ZG, bf16* AB, const float* lnv, const float* wsp, const float* bsp, unsigned char* lds) {
    bf16* GT = (bf16*)lds;
    const int tid = pg8::tid_opaque(), q = tid >> 2, c4 = tid & 3, lane = tid & 63, wave = __builtin_amdgcn_readfirstlane(tid >> 6), fr = lane & 15, fq = lane >> 4;
#pragma unroll 1
    for (int item = blockIdx.x; item < nchunks * 4; item += G) {
        const int ch = item >> 2, g = item & 3; const size_t t0 = (size_t)ch * 128;
        const bf16* src = ZG + (t0 + q) * 1024 + 512 + g * 128 + c4 * 32;
        float v[32]; float s = 0.f;
#pragma unroll
        for (int i = 0; i < 4; ++i) { const u32x4 w = *(const u32x4*)(src + 8 * i);
            v[8 * i + 0] = bflo(w.x); v[8 * i + 1] = bfhi(w.x); v[8 * i + 2] = bflo(w.y); v[8 * i + 3] = bfhi(w.y);
            v[8 * i + 4] = bflo(w.z); v[8 * i + 5] = bfhi(w.z); v[8 * i + 6] = bflo(w.w); v[8 * i + 7] = bfhi(w.w); }
#pragma unroll
        for (int e = 0; e < 32; ++e) s += v[e];
        s += __shfl_xor(s, 1); s += __shfl_xor(s, 2);
        const float mean = s * (1.0f / 128.0f); float qq = 0.f;
#pragma unroll
        for (int e = 0; e < 32; ++e) { v[e] -= mean; qq += v[e] * v[e]; }
        qq += __shfl_xor(qq, 1); qq += __shfl_xor(qq, 2);
        const float rstd = __builtin_amdgcn_rsqf(qq * (1.0f / 128.0f) + EPS);
        bf16x8 wf[4];
        { const float* wrow = wsp + (size_t)(g * 128 + 16 * wave + fr) * 128 + 8 * fq;
#pragma unroll
          for (int ks = 0; ks < 4; ++ks) { const f32x4 w0 = *(const f32x4*)(wrow + 32 * ks), w1 = *(const f32x4*)(wrow + 32 * ks + 4);
              u32x4 pw; pw.x = pk2(w0[0], w0[1]); pw.y = pk2(w0[2], w0[3]); pw.z = pk2(w1[0], w1[1]); pw.w = pk2(w1[2], w1[3]); wf[ks] = __builtin_bit_cast(bf16x8, pw); } }
#pragma unroll
        for (int e = 0; e < 32; e += 4) { const f32x4 gv = *(const f32x4*)(lnv + g * 128 + c4 * 32 + e);
#pragma unroll
            for (int k = 0; k < 4; k += 2) { const unsigned pw = pk2(v[e + k] * rstd * gv[k], v[e + k + 1] * rstd * gv[k + 1]);
                GT[(c4 * 32 + e + k) * 136 + q] = (bf16)(pw & 0xffffu); GT[(c4 * 32 + e + k + 1) * 136 + q] = (bf16)(pw >> 16); } }
        const int p = 16 * wave + fr; const float bias = bsp[g * 128 + p];
        const bf16* up = ZG + (t0 + p) * 1024 + g * 128 + 4 * fq; bf16* op = AB + (t0 + p) * 1024 + g * 128 + 4 * fq;
        u32x2 uv[8];
#pragma unroll
        for (int ct = 0; ct < 8; ++ct) uv[ct] = *(const u32x2*)(up + 16 * ct);
        __syncthreads();
        f32x4 sacc[8];
#pragma unroll
        for (int ct = 0; ct < 8; ++ct) { sacc[ct] = (f32x4){0.f, 0.f, 0.f, 0.f};
#pragma unroll
            for (int ks = 0; ks < 4; ++ks) { const bf16x8 gf = *(const bf16x8*)(GT + (16 * ct + fr) * 136 + 32 * ks + 8 * fq);
                sacc[ct] = __builtin_amdgcn_mfma_f32_16x16x32_bf16(gf, wf[ks], sacc[ct], 0, 0, 0); } }
#pragma unroll
        for (int ct = 0; ct < 8; ++ct) { const u32x2 w = uv[ct]; const f32x4 a = sacc[ct] + bias;
            u32x2 o; o.x = pk2(bflo(w.x) * a[0], bfhi(w.x) * a[1]); o.y = pk2(bflo(w.y) * a[2], bfhi(w.y) * a[3]);
            *(u32x2*)(op + 16 * ct) = o; }
        __syncthreads();
    }
}

__device__ __forceinline__ void attn_mfma_phase(int G, bool with_ctx_q, const bf16* Q, const bf16* K, const bf16* VT, bf16* AB, const float* rpb, unsigned char* lds) {
    const int tid = pg8::tid_opaque(), lane = tid & 63, wave = __builtin_amdgcn_readfirstlane(tid >> 6), fr = lane & 15, fq = lane >> 4;
    constexpr float LOG2E = 1.4426950408889634f, SC = 0.125f * LOG2E;
    float* tab = (float*)lds;
    for (int e = tid; e < 8 * 15 * 64; e += NTHR) { const int h = e / 960, rem = e % 960, dr = rem >> 6, x = (rem & 63) - 16; tab[e] = (x >= 0 && x < 31) ? rpb[(h * 15 + dr) * 31 + x] * LOG2E : 0.f; }
    __syncthreads();
    bf16* Kc = (bf16*)(lds + 32768);
    bf16* Vc = (bf16*)(lds + 69632);
    const int nlat = NB * 8 * 16, ntail = with_ctx_q ? NB * 8 : 0;
    int kit = 0, sub = 0, cur_bh = -1; bool tail = false;
#pragma unroll 1
    for (;;) {
        int item;
        if (!tail) { item = 2 * ((int)blockIdx.x + kit * G) + sub; if (item >= nlat) { tail = true; kit = 0; continue; } if (++sub == 2) { sub = 0; ++kit; } }
        else { const int e2t = (G - 1 - (int)blockIdx.x) + kit * G; if (e2t >= ntail) break; item = nlat + e2t; ++kit; }
        int b, h, qrow[2], rq = 0, kr0 = 0, nrows = 0, c0 = 0, cq = 0; bool loc;
        if (item < nlat) { const int bh = item >> 4, quad = item & 15; h = bh & 7; b = bh >> 3; rq = 4 * quad + 2 * (wave >> 2); const int seg = wave & 3; qrow[0] = b * SEQ + rq * 64 + 16 * seg; qrow[1] = qrow[0] + 64; loc = true;
            kr0 = min(max(rq - 4, 0), 56); nrows = min(max(rq - 3, 0), 56) + 8 - kr0; c0 = seg == 0 ? 0 : (seg == 1 ? 8 : (seg == 2 ? 24 : 32)); cq = 16 * seg + fr; }
        else { const int e2 = item - nlat; h = e2 & 7; b = e2 >> 3; qrow[0] = ML + b * CL + 32 * wave; qrow[1] = qrow[0] + 16; loc = false; }
        if (b * 8 + h != cur_bh) {
            cur_bh = b * 8 + h;
            __syncthreads();
            { const int key = tid >> 1, half = tid & 1; const bf16* src = K + (size_t)(ML + b * CL + key) * 512 + h * 64 + half * 32; bf16* dst = Kc + key * 72 + half * 32;
#pragma unroll
              for (int i = 0; i < 4; ++i) *(u32x4*)(dst + 8 * i) = *(const u32x4*)(src + 8 * i); }
            { const int d = tid >> 3, sg = tid & 7; const bf16* src = VT + (size_t)(h * 64 + d) * MT + ML + b * CL + sg * 32; bf16* dst = Vc + d * 264 + sg * 32;
#pragma unroll
              for (int i = 0; i < 4; ++i) *(u32x4*)(dst + 8 * i) = *(const u32x4*)(src + 8 * i); }
            __syncthreads();
        }
        const int cs = min(max(cq - 8, 0), 48), vlo = cs - c0 - 8 * fq, tb = h * 960 + c0 + 8 * fq - cq + 31;
        bf16x8 qf[2][2];
#pragma unroll
        for (int x = 0; x < 2; ++x)
#pragma unroll
            for (int ds = 0; ds < 2; ++ds) qf[x][ds] = *(const bf16x8*)(Q + (size_t)(qrow[x] + fr) * 512 + h * 64 + 32 * ds + 8 * fq);
        f32x4 oacc[2][4];
#pragma unroll
        for (int x = 0; x < 2; ++x)
#pragma unroll
            for (int dt = 0; dt < 4; ++dt) oacc[x][dt] = (f32x4){0.f, 0.f, 0.f, 0.f};
        float m[2] = {-1e30f, -1e30f}, lsum[2] = {0.f, 0.f};
        const bf16* Kh = K + h * 64 + 8 * fq + (size_t)(8 * (fr >> 2) + (fr & 3)) * 512;
        const bf16* Vh = VT + (size_t)(h * 64 + fr) * MT + 8 * fq;
        bf16x8 kfr[2][2][2];
#define ATT_LOADK(ch_) do { const int np_ = ((ch_) == 4) ? 1 : 2; \
            _Pragma("unroll") for (int p = 0; p < 2; ++p) if (p < np_) { \
                _Pragma("unroll") for (int T = 0; T < 2; ++T) { \
                    if ((ch_) < 5) { const bf16* kp = Kh + ((size_t)b * SEQ + (kr0 + 2 * (ch_) + p) * 64 + c0 + 4 * T) * 512; kfr[p][T][0] = *(const bf16x8*)kp; kfr[p][T][1] = *(const bf16x8*)(kp + 32); } \
                    else { const bf16* kl = Kc + (((ch_) - 5) * 64 + 32 * p + 4 * T + 8 * (fr >> 2) + (fr & 3)) * 72 + 8 * fq; kfr[p][T][0] = *(const bf16x8*)kl; kfr[p][T][1] = *(const bf16x8*)(kl + 32); } } } } while (0)
        int ch = loc ? 0 : 5;
        ATT_LOADK(ch);
#pragma unroll 1
        while (ch < 9) {
            int nch = ch + 1; if (nch == 4 && nrows < 9) nch = 5;
            const bool lch = ch < 5; const int np = (ch == 4) ? 1 : 2;
            bf16x8 vfr[2][4];
#pragma unroll
            for (int p = 0; p < 2; ++p) if (p < np) {
                const size_t kb = (size_t)b * SEQ + (kr0 + 2 * ch + p) * 64 + c0;
#pragma unroll
                for (int dt = 0; dt < 4; ++dt) vfr[p][dt] = lch ? *(const bf16x8*)(Vh + (size_t)(16 * dt) * MT + kb) : *(const bf16x8*)(Vc + (16 * dt + fr) * 264 + (ch - 5) * 64 + 32 * p + 8 * fq);
            }
            f32x4 sv[2][4];
#pragma unroll
            for (int p = 0; p < 2; ++p) {
                if (p < np) {
#pragma unroll
                    for (int T = 0; T < 2; ++T)
#pragma unroll
                        for (int x = 0; x < 2; ++x) { f32x4 acc = (f32x4){0.f, 0.f, 0.f, 0.f};
                            acc = __builtin_amdgcn_mfma_f32_16x16x32_bf16(kfr[p][T][0], qf[x][0], acc, 0, 0, 0);
                            acc = __builtin_amdgcn_mfma_f32_16x16x32_bf16(kfr[p][T][1], qf[x][1], acc, 0, 0, 0);
                            sv[x][2 * p + T] = acc; }
                } else {
#pragma unroll
                    for (int x = 0; x < 2; ++x) { sv[x][2 * p] = (f32x4){-1e30f, -1e30f, -1e30f, -1e30f}; sv[x][2 * p + 1] = (f32x4){-1e30f, -1e30f, -1e30f, -1e30f}; }
                }
            }
            if (nch < 9) ATT_LOADK(nch);
            if (lch) {
#pragma unroll
                for (int x = 0; x < 2; ++x)
#pragma unroll
                    for (int p = 0; p < 2; ++p) if (p < np) { const int kr = kr0 + 2 * ch + p, rx = rq + x, w0 = min(max(rx - 4, 0), 56);
                        const bool rowok = kr >= w0 && kr < w0 + 8; const float* tp = tab + tb + min(max(kr - rx + 7, 0), 14) * 64;
#pragma unroll
                        for (int T = 0; T < 2; ++T)
#pragma unroll
                            for (int r = 0; r < 4; ++r) { const int rel = 4 * T + r - vlo; sv[x][2 * p + T][r] = (rowok && rel >= 0 && rel < 16) ? sv[x][2 * p + T][r] * SC + tp[4 * T + r] : -1e30f; } }
            } else {
#pragma unroll
                for (int x = 0; x < 2; ++x)
#pragma unroll
                    for (int t = 0; t < 4; ++t) sv[x][t] = sv[x][t] * SC;
            }
            bf16x8 pf[2][2];
#pragma unroll
            for (int x = 0; x < 2; ++x) {
                float mx = -1e30f;
#pragma unroll
                for (int t = 0; t < 4; ++t) mx = fmaxf(mx, fmaxf(fmaxf(sv[x][t][0], sv[x][t][1]), fmaxf(sv[x][t][2], sv[x][t][3])));
                mx = fmaxf(mx, __shfl_xor(mx, 16)); mx = fmaxf(mx, __shfl_xor(mx, 32));
                const float mn = fmaxf(m[x], mx), corr = __builtin_amdgcn_exp2f(m[x] - mn); m[x] = mn;
                float ps = 0.f;
#pragma unroll
                for (int t = 0; t < 4; ++t)
#pragma unroll
                    for (int r = 0; r < 4; ++r) { const float pv = __builtin_amdgcn_exp2f(sv[x][t][r] - mn); sv[x][t][r] = pv; ps += pv; }
                lsum[x] = lsum[x] * corr + ps;
#pragma unroll
                for (int dt = 0; dt < 4; ++dt) oacc[x][dt] = oacc[x][dt] * corr;
#pragma unroll
                for (int p = 0; p < 2; ++p) { u32x4 pw; pw.x = pk2(sv[x][2 * p][0], sv[x][2 * p][1]); pw.y = pk2(sv[x][2 * p][2], sv[x][2 * p][3]); pw.z = pk2(sv[x][2 * p + 1][0], sv[x][2 * p + 1][1]); pw.w = pk2(sv[x][2 * p + 1][2], sv[x][2 * p + 1][3]);
                    pf[x][p] = __builtin_bit_cast(bf16x8, pw); }
            }
#pragma unroll
            for (int p = 0; p < 2; ++p) if (p < np) {
#pragma unroll
                for (int dt = 0; dt < 4; ++dt)
#pragma unroll
                    for (int x = 0; x < 2; ++x) oacc[x][dt] = __builtin_amdgcn_mfma_f32_16x16x32_bf16(vfr[p][dt], pf[x][p], oacc[x][dt], 0, 0, 0);
            }
            ch = nch;
        }
#undef ATT_LOADK
#pragma unroll
        for (int x = 0; x < 2; ++x) {
            float ls = lsum[x]; ls += __shfl_xor(ls, 16); ls += __shfl_xor(ls, 32);
            const float inv = __builtin_amdgcn_rcpf(ls);
            bf16* op = AB + (size_t)(qrow[x] + fr) * 1024 + 512 + h * 64 + 4 * fq;
#pragma unroll
            for (int dt = 0; dt < 4; ++dt) { u32x2 w; w.x = pk2(oacc[x][dt][0] * inv, oacc[x][dt][1] * inv); w.y = pk2(oacc[x][dt][2] * inv, oacc[x][dt][3] * inv); *(u32x2*)(op + 16 * dt) = w; }
        }
    }
}

__device__ __forceinline__ float dpp_add(float v, const int ctrl_sel) {
    int r;
    if (ctrl_sel == 0) r = __builtin_amdgcn_update_dpp(0, __builtin_bit_cast(int, v), 0xB1, 0xF, 0xF, true);
    else if (ctrl_sel == 1) r = __builtin_amdgcn_update_dpp(0, __builtin_bit_cast(int, v), 0x4E, 0xF, 0xF, true);
    else if (ctrl_sel == 2) r = __builtin_amdgcn_update_dpp(0, __builtin_bit_cast(int, v), 0x141, 0xF, 0xF, true);
    else r = __builtin_amdgcn_update_dpp(0, __builtin_bit_cast(int, v), 0x140, 0xF, 0xF, true);
    return v + __builtin_bit_cast(float, r);
}
__device__ __forceinline__ float row16_sum(float v) { v = dpp_add(v, 0); v = dpp_add(v, 1); v = dpp_add(v, 2); v = dpp_add(v, 3); return v; }
typedef float f32x2 __attribute__((ext_vector_type(2)));
__device__ __forceinline__ void conv_phase(int G, int nrows, const bf16* GLU, bf16* OUT, const float* wdw, const float* bdw, const float* lng, const float* lnb, unsigned char* lds) {
    constexpr int T = 32, NR = T + 30;
    const int tid = pg8::tid_opaque(), lane = tid & 63, wave = __builtin_amdgcn_readfirstlane(tid >> 6), c0 = 2 * tid;
    float* red = (float*)lds;
    f32x2 w[31];
#pragma unroll
    for (int j = 0; j < 31; ++j) w[j] = *(const f32x2*)(wdw + j * 1024 + c0);
    const f32x2 bd = *(const f32x2*)(bdw + c0), gg = *(const f32x2*)(lng + c0), be = *(const f32x2*)(lnb + c0);
#pragma unroll 1
    for (int tile = blockIdx.x; tile < nrows / T; tile += G) {
        const int t0 = tile * T; int lo, hi;
        if (t0 < ML) { lo = (t0 / SEQ) * SEQ; hi = lo + SEQ; } else { lo = ML + ((t0 - ML) / CL) * CL; hi = lo + CL; }
#define CONV_ROW(dst, rr_) do { const int t = t0 - 15 + (rr_), tc = min(max(t, lo), hi - 1); \
            unsigned msk = (t >= lo && t < hi) ? 0xffffffffu : 0u; asm volatile("" : "+v"(msk));     \
            dst = *(const unsigned*)(GLU + (size_t)tc * D + c0) & msk; } while (0)
        unsigned xa[46], xb[16];
#pragma unroll
        for (int rr = 0; rr < 46; ++rr) CONV_ROW(xa[rr], rr);
        f32x2 acc[T];
#pragma unroll
        for (int t = 0; t < T; ++t) acc[t] = bd;
#pragma unroll
        for (int rr = 0; rr < 46; ++rr) { const f32x2 v = (f32x2){bflo(xa[rr]), bfhi(xa[rr])};
            if (rr < 16) CONV_ROW(xb[rr], 46 + rr);
#pragma unroll
            for (int tt = 0; tt < 16; ++tt) { const int j = rr - tt; if (j >= 0 && j < 31) acc[tt] += w[j] * v; } }
#pragma unroll
        for (int rr = 0; rr < 46; ++rr) { const unsigned xr = (rr < 30) ? xa[16 + rr] : xb[rr - 30]; const f32x2 v = (f32x2){bflo(xr), bfhi(xr)};
#pragma unroll
            for (int tt = 0; tt < 16; ++tt) { const int j = rr - tt; if (j >= 0 && j < 31) acc[16 + tt] += w[j] * v; } }
#undef CONV_ROW
#pragma unroll
        for (int tt = 0; tt < T; ++tt) {
            const float s = row16_sum(acc[tt][0] + acc[tt][1]), qq = row16_sum(acc[tt][0] * acc[tt][0] + acc[tt][1] * acc[tt][1]);
            if ((lane & 15) == 0) { red[(wave * 4 + (lane >> 4)) * (2 * T) + tt] = s; red[(wave * 4 + (lane >> 4)) * (2 * T) + T + tt] = qq; } }
        __syncthreads();
        if (tid < T) { float s = 0.f, q = 0.f;
#pragma unroll
            for (int k = 0; k < 32; ++k) { s += red[k * (2 * T) + tid]; q += red[k * (2 * T) + T + tid]; }
            const float mean = s * (1.0f / D), var = fmaxf(q * (1.0f / D) - mean * mean, 0.f);
            red[32 * 2 * T + 2 * tid] = mean; red[32 * 2 * T + 2 * tid + 1] = __builtin_amdgcn_rsqf(var + EPS); }
        __syncthreads();
#pragma unroll
        for (int tt = 0; tt < T; ++tt) { const f32x2 mr = *(const f32x2*)(red + 32 * 2 * T + 2 * tt); const float mean = mr[0], rstd = mr[1];
            const f32x2 z = (acc[tt] - mean) * rstd * gg + be;
            *(unsigned*)(OUT + (size_t)(t0 + tt) * D + c0) = pk2(z[0] * sigm(z[0]), z[1] * sigm(z[1])); }
        __syncthreads();
    }
}

#define LAS __attribute__((address_space(3)))
#define XB_TMO      128
#define XB_XCNT(j)  (256  + 64 * (j))
#define XB_XSUB(j)  (1280 + 64 * (j))
#define XB_XGEN(j)  (2304 + 64 * (j))
#define XB_TOP      3328
#define XB_TOPGEN   3392
#define XCD_BAR_WORDS 3456
#define XB_SPIN_CAP (1u << 18)

__device__ __forceinline__ unsigned xb_ld(unsigned* p)              { return __hip_atomic_load(p, __ATOMIC_RELAXED, __HIP_MEMORY_SCOPE_AGENT); }
__device__ __forceinline__ unsigned xb_add(unsigned* p, unsigned v) { return __hip_atomic_fetch_add(p, v, __ATOMIC_RELAXED, __HIP_MEMORY_SCOPE_AGENT); }
__device__ __forceinline__ unsigned xb_xcc_id() { return (unsigned)__builtin_amdgcn_s_getreg((3 << 11) | 20) & 0xFu; }
#define XB_SPIN(cond, bar) do { unsigned _sp = 0; while (cond) { __builtin_amdgcn_s_sleep(1); \
    if ((++_sp & 255u) == 0u) { if (xb_ld(&(bar)[XB_TMO])) break; if (_sp > XB_SPIN_CAP) { atomicAdd(&(bar)[XB_TMO], 1u); break; } } } } while (0)

struct XcdBarrier {
    unsigned* bar; unsigned x;
    volatile LAS unsigned* st;
};

__device__ __forceinline__ XcdBarrier xcd_barrier_post(unsigned* bar, volatile LAS unsigned* st) {
    XcdBarrier b; b.bar = bar; b.x = xb_xcc_id(); b.st = st;
    if (threadIdx.x == 0) (void)xb_add(&bar[XB_XCNT(b.x)], 1u);
    return b;
}
__device__ __forceinline__ void xcd_barrier_complete(unsigned* bar, unsigned x, unsigned& nloc, unsigned& nx) {
    const unsigned G = gridDim.x * gridDim.y * gridDim.z;
    unsigned sum, cnt, mine, sp = 0u;
    for (;;) {
        sum = 0u; cnt = 0u; mine = 0u;
#pragma unroll
        for (unsigned j = 0; j < 16; ++j) { const unsigned c = xb_ld(&bar[XB_XCNT(j)]); sum += c; cnt += (c > 0u) ? 1u : 0u; mine = (j == x) ? c : mine; }
        if (sum == G) break;
        __builtin_amdgcn_s_sleep(1);
        if ((++sp & 255u) == 0u) { if (xb_ld(&bar[XB_TMO])) break; if (sp > XB_SPIN_CAP) { atomicAdd(&bar[XB_TMO], 1u); break; } }
    }
    nloc = mine > 0u ? mine : 1u; nx = cnt > 0u ? cnt : 1u;
}

__device__ __forceinline__ void xcd_barrier(const XcdBarrier& b) {
    asm volatile("s_waitcnt vmcnt(0)" ::: "memory");
    __syncthreads();
    if (threadIdx.x == 0) {
        unsigned* bar = b.bar;
        __builtin_amdgcn_s_waitcnt(0);
        unsigned nloc = b.st[0], nx = b.st[1];
        if (nloc == 0u) { xcd_barrier_complete(bar, b.x, nloc, nx); b.st[0] = nloc; b.st[1] = nx; }
        const unsigned old = xb_add(&bar[XB_XSUB(b.x)], 1u);
        const unsigned gen = old / nloc;
        if (old + 1u == (gen + 1u) * nloc) {
            __builtin_amdgcn_fence(__ATOMIC_RELEASE, "agent");
            asm volatile("s_waitcnt vmcnt(0)" ::: "memory");
            const unsigned og = xb_add(&bar[XB_TOP], 1u);
            const unsigned tg = og / nx;
            if (og + 1u == (tg + 1u) * nx) xb_add(&bar[XB_TOPGEN], 1u);
            else XB_SPIN(xb_ld(&bar[XB_TOPGEN]) == tg, bar);
            __builtin_amdgcn_fence(__ATOMIC_ACQUIRE, "agent");
            xb_add(&bar[XB_XGEN(b.x)], 1u);
            asm volatile("s_waitcnt vmcnt(0)" ::: "memory");
        } else {
            XB_SPIN(xb_ld(&bar[XB_XGEN(b.x)]) == gen, bar);
            __builtin_amdgcn_fence(__ATOMIC_ACQUIRE, "agent");
            asm volatile("s_waitcnt vmcnt(0)" ::: "memory");
        }
    }
    __syncthreads();
}

#define GSYNC() xcd_barrier(xbar)
struct Args { const float* in[24]; float* out; unsigned char* ws; };
__global__ void __launch_bounds__(NTHR, 2) fwd_kernel(Args a) {
    extern __shared__ __attribute__((aligned(16))) unsigned char lds[];
    cg::grid_group grid = cg::this_grid();
    const int G = gridDim.x, bx = blockIdx.x;
    unsigned char* ws = a.ws;
    PG8_LAS unsigned char* ldsl = (PG8_LAS unsigned char*)lds;
    const float* MOD = (const float*)(ws + WS_MOD);
    float* X = (float*)(ws + WS_X); bf16* H = (bf16*)(ws + WS_H);
    bf16* ZG = (bf16*)(ws + WS_R + R_ZG); bf16* Qb = (bf16*)(ws + WS_R + R_Q); bf16* Kb = (bf16*)(ws + WS_R + R_K); bf16* VT = (bf16*)(ws + WS_R + R_VT); bf16* AB = (bf16*)(ws + WS_R + R_AB);
    bf16* Fb = (bf16*)(ws + WS_R); float* PART = (float*)(ws + WS_PART); float* SS = (float*)(ws + WS_SS); const float* BIASW = (const float*)(ws + WS_BIASW);
    const float* x_in = a.in[0]; const float* ctx_in = a.in[2];
    if (threadIdx.x < 16) ((volatile LAS unsigned*)(ldsl + LDS_BYTES - 64))[threadIdx.x] = 0u;
    __syncthreads();

    const XcdBarrier xbar = xcd_barrier_post((unsigned*)ws, (volatile LAS unsigned*)(ldsl + LDS_BYTES - 64));
    if (gridDim.x == 0x7fffffffu) grid.sync();
    p0a_phase(G, a.in, ws, lds);
    GSYNC();
    p0b_phase(G, a.in, ws, lds);
    GSYNC();
#pragma unroll 1
    for (int l = 0; l < DEPTH; ++l) {
        const int i = l >> 1, sA = 2 * l, sB = 2 * l + 1;
        const float* modl = MOD + (size_t)l * 5 * 6144;
        const int M1 = (l <= 2) ? MT : ML;
        const int M2 = (l < 2) ? MT : ML;

        if ((l & 1) == 0) {
            { const bf16* W = (const bf16*)(ws + WS_WIN) + (size_t)i * 2560 * D;
              pg8::Gemm g{H, W, M1, 2048, D, W + (size_t)2048 * D, H}; pg8::StaticOrder S; S.init(M1, 2048, D, G, bx, 512, M1);
              EpiWin E{ZG, Qb, Kb, VT, SS + (size_t)sA * MT * 4, BIASW + (size_t)sA * 5 * 4096};
              pg8::gemm_phase<EpiWin, pg8::StaticOrder, true, true>(ldsl, g, S, E); }
            GSYNC();
            gating_phase(G, (l == 0 ? MT : ML) / 128, ZG, AB, a.in[9] + i * 512, a.in[10] + (size_t)i * 4 * 128 * 128, a.in[11] + i * 512, lds);
            __syncthreads();
            attn_mfma_phase(G, l == 0, Qb, Kb, VT, AB, a.in[12] + (size_t)i * 8 * 15 * 31, lds);
            GSYNC();
            { pg8::Gemm g{AB, (const bf16*)(ws + WS_WOUT) + (size_t)i * D * D, M2, D, D, nullptr, nullptr}; pg8::StaticOrder S; S.init(M2, D, D, G, bx);
              EpiRes<false, false> E{H, a.in[6] + (size_t)sA * D, modl + 1024, a.in[6] + (size_t)sB * D, modl + 4096, modl + 2048, nullptr, nullptr, SS + (size_t)sB * MT * 4, nullptr, (float*)(lds + 131072)};
              pg8::gemm_phase<EpiRes<false, false>, pg8::StaticOrder, true, true>(ldsl, g, S, E); }
        } else {
            { pg8::Gemm g{H, (const bf16*)(ws + WS_WPW1) + (size_t)i * 2048 * D, M2, 2048, D, nullptr, nullptr}; pg8::StaticOrder S; S.init(M2, 2048, D, G, bx);
              EpiGlu E{ZG, a.in[14] + i * 2048, SS + (size_t)sA * MT * 4, BIASW + (size_t)sA * 5 * 4096};
              pg8::gemm_phase<EpiGlu, pg8::StaticOrder, true, true>(ldsl, g, S, E); }
            GSYNC();
            conv_phase(G, M2, ZG, AB, a.in[15] + (size_t)i * 31 * D, a.in[16] + i * D, a.in[17] + i * D, a.in[18] + i * D, lds);
            GSYNC();
            { pg8::Gemm g{AB, (const bf16*)(ws + WS_WPW2) + (size_t)i * D * D, M2, D, D, nullptr, nullptr}; pg8::StaticOrder S; S.init(M2, D, D, G, bx);
              EpiRes<true, false> E{H, a.in[6] + (size_t)sA * D, modl + 1024, a.in[6] + (size_t)sB * D, modl + 4096, modl + 2048, a.in[20] + i * D, nullptr, SS + (size_t)sB * MT * 4, nullptr, (float*)(lds + 131072)};
              pg8::gemm_phase<EpiRes<true, false>, pg8::StaticOrder, true, true>(ldsl, g, S, E); }
        }
        GSYNC();
        { pg8::Gemm g{H, (const bf16*)(ws + WS_WFF1) + (size_t)l * FF * D, M2, FF, D, nullptr, nullptr}; pg8::StaticOrder S; S.init(M2, FF, D, G, bx);
          EpiFF1 E{Fb, SS + (size_t)sB * MT * 4, BIASW + (size_t)sB * 5 * 4096};
          pg8::gemm_phase<EpiFF1, pg8::StaticOrder, true, true>(ldsl, g, S, E); }
        GSYNC();
        { pg8::Gemm g{Fb, (const bf16*)(ws + WS_WFF2) + (size_t)l * D * FF, M2, D, FF, nullptr, nullptr}; pg8::StaticOrder S; S.init(ML, D, FF, G, bx, 0, 0, M2 - ML, 8);
          if (l < 3) { EpiRes<false, false> E{H, a.in[6] + (size_t)sB * D, modl + 4096, a.in[6] + (size_t)(sB + 1) * D, MOD + (size_t)(l + 1) * 5 * 6144 + 1024, modl + 5120, nullptr, PART, SS + (size_t)(sB + 1) * MT * 4, nullptr, (float*)(lds + 131072)};
            pg8::gemm_phase<EpiRes<false, false>, pg8::StaticOrder, true, true>(ldsl, g, S, E); }
          else { EpiRes<false, true> E{H, a.in[6] + (size_t)sB * D, modl + 4096, nullptr, nullptr, modl + 5120, nullptr, PART, SS + (size_t)(sB + 1) * MT * 4, X, (float*)(lds + 131072)};
            pg8::gemm_phase<EpiRes<false, true>, pg8::StaticOrder, true, true>(ldsl, g, S, E); } }

        GSYNC();
        if (l < 2) {
            fold_rows(G, H, PART, 8, a.in[6] + (size_t)sB * D, modl + 4096, a.in[6] + (size_t)(sB + 1) * D, MOD + (size_t)(l + 1) * 5 * 6144 + 1024, SS + (size_t)(sB + 1) * MT * 4);
            GSYNC();
        }
    }
    final_phase(G, H, SS + (size_t)8 * MT * 4, a.in[23], a.out);
}

extern "C" void kernel_launch(void* const* d_in, const int* in_sizes, int n_in, void* d_out, int out_size, void* d_ws, size_t ws_size, hipStream_t stream) {
    static int grid = 0;
    if (grid == 0) {
        int dev = 0, cus = 0, per_cu = 0;
        if (n_in != 24 || ws_size < WS_END) { fprintf(stderr, "kernel_launch: unexpected n_in %d / ws %zu\n", n_in, ws_size); grid = -1; return; }
        hipGetDevice(&dev); hipDeviceGetAttribute(&cus, hipDeviceAttributeMultiprocessorCount, dev);
        hipFuncSetAttribute((const void*)fwd_kernel, hipFuncAttributeMaxDynamicSharedMemorySize, LDS_BYTES);
        hipOccupancyMaxActiveBlocksPerMultiprocessor(&per_cu, (const void*)fwd_kernel, NTHR, LDS_BYTES);
        if (per_cu < 1 || cus < 1) { fprintf(stderr, "kernel_launch: occupancy %d cus %d\n", per_cu, cus); grid = -1; return; }
        grid = cus * per_cu;
    }
    if (grid < 0) return;
    Args a{};
    for (int i = 0; i < 24; ++i) a.in[i] = (const float*)d_in[i];
    a.out = (float*)d_out; a.ws = (unsigned char*)d_ws;
    if (hipMemsetAsync(d_ws, 0, XCD_BAR_WORDS * sizeof(unsigned), stream) != hipSuccess) { fprintf(stderr, "kernel_launch: memset of the barrier words failed\n"); return; }
    void* args[] = {&a};
    hipError_t e = hipLaunchCooperativeKernel((const void*)fwd_kernel, dim3(grid), dim3(NTHR), args, LDS_BYTES, stream);
    if (e != hipSuccess) fprintf(stderr, "cooperative launch failed: %s (grid %d)\n", hipGetErrorString(e), grid);
}
```

```cpp
#include <hip/hip_runtime.h>
#include <hip/hip_cooperative_groups.h>
#include <cstdio>
#include <cstdint>
namespace cg = cooperative_groups;

namespace pg8 {
#define PG8_LAS __attribute__((address_space(3)))
typedef unsigned short bf16_t;
typedef short bf16x8 __attribute__((ext_vector_type(8)));
typedef float f32x4 __attribute__((ext_vector_type(4)));
typedef unsigned u32x4 __attribute__((ext_vector_type(4)));
constexpr int BM = 256, BK = 64, HALF = 128, HTB = HALF * BK * 2  , STAGE_BYTES = 8 * HTB, NXCD = 8, WGM = 8;

__host__ __device__ __forceinline__ int lds_byte(int r, int c) { const int st = (r >> 4) * 2 + (c >> 5), rr = r & 15, cc = c & 31, ob = rr * 64 + cc * 2; return st * 1024 + (ob ^ (((ob >> 9) & 1) << 5)); }
__host__ __device__ __forceinline__ void stage_rc(int b, int& R, int& C) { const int st = b / 1024, sb = b % 1024, swz = sb ^ (((sb >> 9) & 1) << 5); R = (st >> 1) * 16 + swz / 64; C = (st & 1) * 32 + (swz % 64) / 2; }
__host__ __device__ __forceinline__ int perm32(int rho) { const int n = rho >> 4, i = rho & 15; return 8 * (i >> 2) + 4 * n + (i & 3); }

__device__ __forceinline__ int tid_opaque() { int t = threadIdx.x; asm volatile("" : "+v"(t)); return t; }
struct Unit { int pm, pn, kind, kt0, knt; };
struct Gemm { const bf16_t* A; const bf16_t* Bt; int M, N, K; const bf16_t* A2; const bf16_t* Bt2; };

struct StaticOrder {
    int nM, nN, nwg, G, c, nM2, nN2, nwg2, nMs, nsplit, nws, ntf;
    __device__ void init(int M, int N, int K, int G_, int c_, int M2 = 0, int N2 = 0, int Ms = 0, int splits = 1) { nM = M / BM; nN = N / BM; nwg = nM * nN; G = G_; c = c_; nM2 = M2 / BM; nN2 = N2 / BM; nwg2 = nM2 * nN2;
        nMs = Ms / BM; nsplit = splits; nws = nMs * nN * splits; ntf = K / BK; }
    __device__ static void map(int wgid, int nwg_, int nM_, int nN_, Unit& u) {
        { const int q = nwg_ / NXCD, r = nwg_ % NXCD, xcd = wgid % NXCD, off = wgid / NXCD; wgid = (xcd < r ? xcd * (q + 1) : r * (q + 1) + (xcd - r) * q) + off; }
        const int nig = WGM * nN_, gid = wgid / nig, fm = gid * WGM, gsz = (nM_ - fm) < WGM ? (nM_ - fm) : WGM;
        u.pm = fm + ((wgid % nig) % gsz); u.pn = (wgid % nig) / gsz;
    }
    __device__ bool next(int i, Unit& u) const {
        const long L = (long)i * G + c; if (L >= nwg + nwg2 + nws) return false;
        u.kt0 = 0; u.knt = ntf;
        if (L < nwg) { map((int)L, nwg, nM, nN, u); u.kind = 0; }
        else if (L < nwg + nwg2) { const int e = (int)L - nwg; u.pm = e % nM2; u.pn = e / nM2; u.kind = 1; }
        else { const int e = (int)L - nwg - nwg2, part = e % nsplit, tile = e / nsplit; u.pm = nM + tile % nMs; u.pn = tile / nMs; u.kind = 2; u.knt = ntf / nsplit; u.kt0 = part * u.knt; }
        return true;
    }
    __device__ __forceinline__ void a_ready(const Unit&) const {}
    __device__ __forceinline__ void done(const Unit&) const {}
};

__device__ __forceinline__ unsigned cvt_pk_bf16(float lo, float hi) { unsigned r; asm volatile("v_cvt_pk_bf16_f32 %0, %1, %2" : "=v"(r) : "v"(lo), "v"(hi)); return r; }

template <class Epi, class Sched, bool ALIGN_EPI = false, bool SP2 = false>
__device__ __forceinline__ void gemm_phase(PG8_LAS unsigned char* lds, const Gemm g, const Sched& S, const Epi& E) {
    const int tid = tid_opaque(), wid = __builtin_amdgcn_readfirstlane(tid >> 6), lane = tid & 63, wr = wid >> 2, wc = wid & 3, fr = lane & 15, fq = lane >> 4;
    const int K = g.K, nt = K / BK;
    unsigned voffA[2], voffB[2];
#pragma unroll
    for (int i = 0; i < 2; ++i) { int R, C; stage_rc(tid * 16 + i * 8192, R, C); const int Rb = Epi::PERM ? ((R & ~31) + perm32(R & 31)) : R;
        voffA[i] = (unsigned)(R * K + C) * 2u; voffB[i] = (unsigned)(Rb * K + C) * 2u; }
    const size_t kstep = (size_t)(BK * 2);
    const size_t hstep = (size_t)HALF * K * 2;
    const size_t tstep = 2 * hstep;
    const unsigned ldsw = (unsigned)wid * 1024u;
    const int aoff = lds_byte(wr * 64 + fr, fq * 8), boff = lds_byte(wc * 32 + fr, fq * 8);
#define PG8_SA(b, h) (((b) * 2 + (h)) * HTB)
#define PG8_SB(b, h) ((4 + (b) * 2 + (h)) * HTB)
#define PG8_STAGE(bufoff, gbase, voff) do { _Pragma("unroll") for (int _i = 0; _i < 2; ++_i) \
        __builtin_amdgcn_global_load_lds((const unsigned*)((const char*)(gbase) + (voff)[_i]), (PG8_LAS unsigned*)(lds + (bufoff) + ldsw + _i * 8192), 16, 0, 0); } while (0)
#define PG8_LDA(dst, b, h) do { _Pragma("unroll") for (int m = 0; m < 4; ++m) _Pragma("unroll") for (int k = 0; k < 2; ++k) dst[m][k] = *(const PG8_LAS bf16x8*)(lds + PG8_SA(b, h) + aoff + m * 2048 + k * 1024); } while (0)
#define PG8_LDB(dst, b, h) do { _Pragma("unroll") for (int n = 0; n < 2; ++n) _Pragma("unroll") for (int k = 0; k < 2; ++k) dst[n][k] = *(const PG8_LAS bf16x8*)(lds + PG8_SB(b, h) + boff + n * 2048 + k * 1024); } while (0)
#define PG8_MMA(ai, bj, At, Bt) do { __builtin_amdgcn_s_setprio(1); _Pragma("unroll") for (int m = 0; m < 4; ++m) _Pragma("unroll") for (int n = 0; n < 2; ++n) _Pragma("unroll") for (int k = 0; k < 2; ++k) \
        acc[ai][bj][m][n] = __builtin_amdgcn_mfma_f32_16x16x32_bf16(Bt[n][k], At[m][k], acc[ai][bj][m][n], 0, 0, 0); __builtin_amdgcn_s_setprio(0); } while (0)
#define PG8_WAIT_V(n) asm volatile("s_waitcnt vmcnt(" #n ")" ::: "memory")
#define PG8_WAIT_L(n) asm volatile("s_waitcnt lgkmcnt(" #n ")" ::: "memory")
#define PG8_BAR __builtin_amdgcn_s_barrier()
#define PG8_SCHED __builtin_amdgcn_sched_barrier(0)
    Unit cur, nxt; int ui = 0;
    if (!S.next(0, cur)) return;
    f32x4 acc[2][2][4][2];
#pragma unroll
    for (int a = 0; a < 2; ++a)
#pragma unroll
        for (int b = 0; b < 2; ++b)
#pragma unroll
            for (int m = 0; m < 4; ++m)
#pragma unroll
                for (int n = 0; n < 2; ++n) acc[a][b][m][n] = (f32x4){0.f, 0.f, 0.f, 0.f};
    typename Epi::Pre pre; E.preload(pre, cur, wr, wc, fr, fq);
    if constexpr (Epi::ACC_INIT) E.init_acc(acc, cur, wr, wc, fr, fq, pre);
    bf16x8 At[4][2], B0[2][2], B1[2][2];
    const char* cA = (const char*)(cur.kind == 1 ? g.A2 : g.A) + (size_t)cur.pm * tstep + (size_t)cur.kt0 * kstep; const char* cB = (const char*)(cur.kind == 1 ? g.Bt2 : g.Bt) + (size_t)cur.pn * tstep + (size_t)cur.kt0 * kstep;
    S.a_ready(cur);
    if constexpr (SP2) {
        PG8_STAGE(PG8_SB(0, 0), cB, voffB); PG8_STAGE(PG8_SB(0, 1), cB + hstep, voffB); PG8_STAGE(PG8_SA(0, 0), cA, voffA); PG8_STAGE(PG8_SA(0, 1), cA + hstep, voffA);
        if (wr == 1) PG8_BAR;
        PG8_WAIT_V(2); PG8_BAR;
        PG8_STAGE(PG8_SB(1, 0), cB + kstep, voffB); PG8_STAGE(PG8_SA(1, 0), cA + kstep, voffA); PG8_STAGE(PG8_SB(1, 1), cB + hstep + kstep, voffB);
        PG8_WAIT_V(6); PG8_BAR;
    } else {
        PG8_STAGE(PG8_SB(0, 0), cB, voffB); PG8_STAGE(PG8_SA(0, 0), cA, voffA); PG8_STAGE(PG8_SB(0, 1), cB + hstep, voffB); PG8_STAGE(PG8_SA(0, 1), cA + hstep, voffA);
        if (wr == 1) PG8_BAR;
        PG8_WAIT_V(4); PG8_BAR;
        PG8_STAGE(PG8_SB(1, 0), cB + kstep, voffB); PG8_STAGE(PG8_SA(1, 0), cA + kstep, voffA); PG8_STAGE(PG8_SB(1, 1), cB + hstep + kstep, voffB);
        PG8_WAIT_V(6); PG8_BAR;
    }
    for (;;) {
        const bool has_next = S.next(ui + 1, nxt);
        const char* nA = has_next ? (const char*)(nxt.kind == 1 ? g.A2 : g.A) + (size_t)nxt.pm * tstep + (size_t)nxt.kt0 * kstep : cA; const char* nB = has_next ? (const char*)(nxt.kind == 1 ? g.Bt2 : g.Bt) + (size_t)nxt.pn * tstep + (size_t)nxt.kt0 * kstep : cB;
        const int cnt = cur.knt;
        for (int t = 0; t < cnt; t += 2) {
            const bool last = (t == cnt - 2);
            const char* a1 = cA + (size_t)(t + 1) * kstep;
            const char* a2 = last ? nA : cA + (size_t)(t + 2) * kstep; const char* b2 = last ? nB : cB + (size_t)(t + 2) * kstep;
            const char* a3 = a2 + kstep; const char* b3 = b2 + kstep;
            if (last && has_next) S.a_ready(nxt);
            if constexpr (SP2) {
            PG8_LDB(B0, 0, 0); PG8_LDB(B1, 0, 1); PG8_SCHED; PG8_LDA(At, 0, 0); PG8_STAGE(PG8_SA(1, 1), a1 + hstep, voffA);
            PG8_WAIT_V(8); PG8_WAIT_L(0); PG8_BAR; PG8_MMA(0, 0, At, B0); PG8_MMA(0, 1, At, B1); PG8_BAR; PG8_SCHED;
            PG8_LDA(At, 0, 1); PG8_STAGE(PG8_SB(0, 0), b2, voffB); PG8_STAGE(PG8_SB(0, 1), b2 + hstep, voffB); PG8_STAGE(PG8_SA(0, 0), a2, voffA);
            PG8_WAIT_V(8); PG8_WAIT_L(0); PG8_BAR; PG8_MMA(1, 0, At, B0); PG8_MMA(1, 1, At, B1); PG8_BAR; PG8_SCHED;
            PG8_LDB(B0, 1, 0); PG8_LDB(B1, 1, 1); PG8_SCHED; PG8_LDA(At, 1, 0); PG8_STAGE(PG8_SA(0, 1), a2 + hstep, voffA);
            PG8_WAIT_V(8); PG8_WAIT_L(0); PG8_BAR; PG8_MMA(0, 0, At, B0); PG8_MMA(0, 1, At, B1); PG8_BAR; PG8_SCHED;
            PG8_LDA(At, 1, 1); PG8_STAGE(PG8_SB(1, 0), b3, voffB); PG8_STAGE(PG8_SB(1, 1), b3 + hstep, voffB); PG8_STAGE(PG8_SA(1, 0), a3, voffA);
            PG8_WAIT_V(8); PG8_WAIT_L(0); PG8_BAR; PG8_MMA(1, 0, At, B0); PG8_MMA(1, 1, At, B1); PG8_BAR; PG8_SCHED;
            } else {
            PG8_LDB(B0, 0, 0); PG8_SCHED; PG8_LDA(At, 0, 0); PG8_STAGE(PG8_SA(1, 1), a1 + hstep, voffA);
            PG8_WAIT_L(8); PG8_BAR; PG8_WAIT_L(0); PG8_MMA(0, 0, At, B0); PG8_BAR; PG8_SCHED;
            PG8_LDB(B1, 0, 1); PG8_STAGE(PG8_SB(0, 0), b2, voffB);
            PG8_BAR; PG8_WAIT_L(0); PG8_MMA(0, 1, At, B1); PG8_BAR;
            PG8_LDA(At, 0, 1); PG8_STAGE(PG8_SA(0, 0), a2, voffA);
            PG8_BAR; PG8_WAIT_L(0); PG8_MMA(1, 0, At, B0); PG8_BAR; PG8_SCHED;
            PG8_STAGE(PG8_SB(0, 1), b2 + hstep, voffB);
            PG8_WAIT_V(6); PG8_BAR; PG8_MMA(1, 1, At, B1); PG8_BAR;
            PG8_LDB(B0, 1, 0); PG8_SCHED; PG8_LDA(At, 1, 0); PG8_STAGE(PG8_SA(0, 1), a2 + hstep, voffA);
            PG8_WAIT_L(8); PG8_BAR; PG8_WAIT_L(0); PG8_MMA(0, 0, At, B0); PG8_BAR; PG8_SCHED;
            PG8_LDB(B1, 1, 1); PG8_STAGE(PG8_SB(1, 0), b3, voffB);
            PG8_BAR; PG8_WAIT_L(0); PG8_MMA(0, 1, At, B1); PG8_BAR;
            PG8_LDA(At, 1, 1); PG8_STAGE(PG8_SA(1, 0), a3, voffA);
            PG8_BAR; PG8_WAIT_L(0); PG8_MMA(1, 0, At, B0); PG8_BAR; PG8_SCHED;
            PG8_STAGE(PG8_SB(1, 1), b3 + hstep, voffB);
            PG8_WAIT_V(6); PG8_BAR; PG8_MMA(1, 1, At, B1); PG8_BAR;
            }
        }
        if constexpr (ALIGN_EPI) { if (wr == 0) PG8_BAR; }
        if constexpr (!Epi::AFTER_DRAIN) { E(acc, cur, wr, wc, fr, fq, pre); S.done(cur); }
        if (!has_next) break;
#pragma unroll
        for (int a = 0; a < 2; ++a)
#pragma unroll
            for (int b = 0; b < 2; ++b)
#pragma unroll
                for (int m = 0; m < 4; ++m)
#pragma unroll
                    for (int n = 0; n < 2; ++n) acc[a][b][m][n] = (f32x4){0.f, 0.f, 0.f, 0.f};
        cur = nxt; cA = nA; cB = nB; ++ui;
        E.preload(pre, cur, wr, wc, fr, fq);
        if constexpr (Epi::ACC_INIT) E.init_acc(acc, cur, wr, wc, fr, fq, pre);
        if constexpr (ALIGN_EPI) { if (wr == 1) PG8_BAR; }
    }
    PG8_WAIT_V(0);
    if constexpr (!ALIGN_EPI) { if (wr == 0) PG8_BAR; }
    PG8_BAR;
    if constexpr (Epi::AFTER_DRAIN) { E.fused(acc, cur, wr, wc, fr, fq, lds, wid, lane); S.done(cur); }
#undef PG8_SA
#undef PG8_SB
#undef PG8_STAGE
#undef PG8_LDA
#undef PG8_LDB
#undef PG8_MMA
#undef PG8_WAIT_V
#undef PG8_WAIT_L
#undef PG8_BAR
#undef PG8_SCHED
}
}

typedef unsigned short bf16;
typedef float f32x4 __attribute__((ext_vector_type(4)));
typedef unsigned u32x4 __attribute__((ext_vector_type(4)));
typedef unsigned u32x2 __attribute__((ext_vector_type(2)));
typedef short bf16x8 __attribute__((ext_vector_type(8)));

constexpr int D = 1024, NB = 4, SEQ = 4096, ML = NB * SEQ, CL = 256, MC = NB * CL, MT = ML + MC, FF = 4096, DEPTH = 4;
constexpr int NTHR = 512;
constexpr float EPS = 1e-6f;
constexpr size_t MiB = 1u << 20;
constexpr size_t WS_MOD = 1 * MiB, WS_WIN = 2 * MiB, WS_WOUT = 12 * MiB, WS_WPW1 = 16 * MiB, WS_WPW2 = 24 * MiB, WS_WFF1 = 28 * MiB, WS_WFF2 = 60 * MiB;
constexpr size_t WS_X = 92 * MiB, WS_H = 160 * MiB, WS_R = 194 * MiB, WS_PART = 330 * MiB  , WS_SS = 362 * MiB  , WS_BIASW = 365 * MiB  , WS_END = 366 * MiB;
constexpr size_t R_ZG = 0, R_Q = 34 * MiB, R_K = 51 * MiB, R_VT = 68 * MiB, R_AB = 85 * MiB;
constexpr int LDS_BYTES = 147456;

__device__ __forceinline__ float bf2f(unsigned short b) { return __builtin_bit_cast(float, (unsigned)b << 16); }
__device__ __forceinline__ float bflo(unsigned u) { return __builtin_bit_cast(float, u << 16); }
__device__ __forceinline__ float bfhi(unsigned u) { return __builtin_bit_cast(float, u & 0xffff0000u); }
__device__ __forceinline__ unsigned pk2(float lo, float hi) { return pg8::cvt_pk_bf16(lo, hi); }
__device__ __forceinline__ float fexp(float x) { return __builtin_amdgcn_exp2f(x * 1.4426950408889634f); }
__device__ __forceinline__ float sigm(float x) { return __builtin_amdgcn_rcpf(1.f + fexp(-x)); }
__device__ __forceinline__ float gelu_tanh(float x) { const float y = 0.7978845608028654f * (x + 0.044715f * x * x * x); return x * sigm(2.f * y); }
__device__ __forceinline__ float wave_sum(float v) {
#pragma unroll
    for (int o = 1; o < 64; o <<= 1) v += __shfl_xor(v, o);
    return v;
}

__device__ __forceinline__ float rstd_of(float ss) { return __builtin_amdgcn_rsqf(ss * (1.0f / 1024.0f) + 1e-6f); }
__device__ __forceinline__ float ss_row(const float* ssp, int row) { const f32x4 p = *(const f32x4*)(ssp + (size_t)row * 4); return (p[0] + p[1]) + (p[2] + p[3]); }
struct EpiWin {
    static constexpr bool PERM = true, AFTER_DRAIN = false, ACC_INIT = true;
    bf16 *ZG, *Q, *K, *VT; const float* ss; const float* bw  ;
    struct Pre { float v[16]; };
    __device__ __forceinline__ void preload(Pre& p, const pg8::Unit& u, int wr, int wc, int fr, int fq) const {
        if (u.kind) { const int col0 = u.pn * 256 + wc * 32 + 8 * fq;
#pragma unroll
            for (int j = 0; j < 16; ++j) p.v[j] = ss_row(ss, col0 + (j >> 3) * 128 + (j & 7)); }
        else { const int row0 = u.pm * 256 + wr * 64 + fr;
#pragma unroll
            for (int j = 0; j < 8; ++j) p.v[j] = ss_row(ss, row0 + (j >> 2) * 128 + (j & 3) * 16);
#pragma unroll
            for (int j = 8; j < 16; ++j) p.v[j] = 0.f; }
    }
    __device__ __forceinline__ void init_acc(f32x4 (&acc)[2][2][4][2], const pg8::Unit& u, int wr, int wc, int fr, int fq, const Pre& p) const {
        if (u.kind) {
            const int row0 = u.pm * 256 + wr * 64 + fr, bi = u.pn < (ML / 256) ? u.pn / (SEQ / 256) : 4;
            f32x4 ir[2][2];
#pragma unroll
            for (int bj = 0; bj < 2; ++bj)
#pragma unroll
                for (int n = 0; n < 2; ++n)
#pragma unroll
                    for (int e = 0; e < 4; ++e) ir[bj][n][e] = __builtin_amdgcn_sqrtf(p.v[bj * 8 + n * 4 + e] * (1.0f / 1024.0f) + 1e-6f);
#pragma unroll
            for (int ai = 0; ai < 2; ++ai)
#pragma unroll
                for (int m = 0; m < 4; ++m) { const float bb = bw[bi * 4096 + 2048 + row0 + ai * 128 + m * 16];
#pragma unroll
                    for (int bj = 0; bj < 2; ++bj)
#pragma unroll
                        for (int n = 0; n < 2; ++n) acc[ai][bj][m][n] = ir[bj][n] * bb; }
        } else {
            const int col0 = u.pn * 256 + wc * 32 + 8 * fq, bi = u.pm < (ML / 256) ? u.pm / (SEQ / 256) : 4;
            float ir[8];
#pragma unroll
            for (int j = 0; j < 8; ++j) ir[j] = __builtin_amdgcn_sqrtf(p.v[j] * (1.0f / 1024.0f) + 1e-6f);
#pragma unroll
            for (int bj = 0; bj < 2; ++bj)
#pragma unroll
                for (int n = 0; n < 2; ++n) { const f32x4 bsv = *(const f32x4*)(bw + bi * 4096 + col0 + bj * 128 + 4 * n);
#pragma unroll
                    for (int ai = 0; ai < 2; ++ai)
#pragma unroll
                        for (int m = 0; m < 4; ++m) acc[ai][bj][m][n] = bsv * ir[ai * 4 + m]; }
        }
    }
    __device__ __forceinline__ void operator()(const f32x4 (&acc)[2][2][4][2], const pg8::Unit& u, int wr, int wc, int fr, int fq, const Pre& p) const {
        const int row0 = u.pm * 256 + wr * 64 + fr; const int col0 = u.pn * 256 + wc * 32 + 8 * fq; int cb = col0;
        if (u.kind) {
            f32x4 rs[2][2];
#pragma unroll
            for (int bj = 0; bj < 2; ++bj)
#pragma unroll
                for (int n = 0; n < 2; ++n)
#pragma unroll
                    for (int e = 0; e < 4; ++e) rs[bj][n][e] = rstd_of(p.v[bj * 8 + n * 4 + e]);
#pragma unroll
            for (int ai = 0; ai < 2; ++ai)
#pragma unroll
                for (int m = 0; m < 4; ++m) { const int row = row0 + ai * 128 + m * 16; bf16* rowp = VT + (size_t)row * MT + cb;
#pragma unroll
                    for (int bj = 0; bj < 2; ++bj) { const f32x4 v0 = acc[ai][bj][m][0] * rs[bj][0], v1 = acc[ai][bj][m][1] * rs[bj][1];
                        u32x4 w; w.x = pk2(v0[0], v0[1]); w.y = pk2(v0[2], v0[3]); w.z = pk2(v1[0], v1[1]); w.w = pk2(v1[2], v1[3]);
                        *(u32x4*)(rowp + bj * 128) = w; } }
            return;
        }
        bf16* base; int ld; bool act = false;
        if (u.pn < 4) { base = ZG; ld = 1024; act = true; }
        else if (u.pn < 6) { base = Q; ld = 512; cb -= 1024; }
        else { base = K; ld = 512; cb -= 1536; }
#pragma unroll
        for (int ai = 0; ai < 2; ++ai)
#pragma unroll
            for (int m = 0; m < 4; ++m) { const int row = row0 + ai * 128 + m * 16; const float rs = rstd_of(p.v[ai * 4 + m]); bf16* rowp = base + (size_t)row * ld + cb;
#pragma unroll
                for (int bj = 0; bj < 2; ++bj) { f32x4 v0 = acc[ai][bj][m][0] * rs, v1 = acc[ai][bj][m][1] * rs;
                    if (act) {
#pragma unroll
                        for (int e = 0; e < 4; ++e) { v0[e] = gelu_tanh(v0[e]); v1[e] = gelu_tanh(v1[e]); } }
                    u32x4 w; w.x = pk2(v0[0], v0[1]); w.y = pk2(v0[2], v0[3]); w.z = pk2(v1[0], v1[1]); w.w = pk2(v1[2], v1[3]);
                    *(u32x4*)(rowp + bj * 128) = w; } }
    }
};
struct EpiGlu {
    static constexpr bool PERM = true, AFTER_DRAIN = false, ACC_INIT = true;
    bf16* O; const float* b1; const float* ss; const float* bw;
    struct Pre { float ssv[2][4]; };
    __device__ __forceinline__ void preload(Pre& p, const pg8::Unit& u, int wr, int wc, int fr, int fq) const {
        const int row0 = u.pm * 256 + wr * 64 + fr;
#pragma unroll
        for (int ai = 0; ai < 2; ++ai)
#pragma unroll
            for (int m = 0; m < 4; ++m) p.ssv[ai][m] = ss_row(ss, row0 + ai * 128 + m * 16);
    }
    __device__ __forceinline__ void init_acc(f32x4 (&acc)[2][2][4][2], const pg8::Unit& u, int wr, int wc, int fr, int fq, const Pre& p) const {
        const int ch0 = u.pn * 128 + wc * 32 + 8 * fq, bi = u.pm < (ML / 256) ? u.pm / (SEQ / 256) : 4; const float* bwb = bw + bi * 4096;
        float ir[2][4];
#pragma unroll
        for (int ai = 0; ai < 2; ++ai)
#pragma unroll
            for (int m = 0; m < 4; ++m) ir[ai][m] = __builtin_amdgcn_sqrtf(p.ssv[ai][m] * (1.0f / 1024.0f) + 1e-6f);
#pragma unroll
        for (int bj = 0; bj < 2; ++bj)
#pragma unroll
            for (int n = 0; n < 2; ++n) { const int c = bj * 1024 + ch0 + 4 * n; const f32x4 bsv = *(const f32x4*)(b1 + c) + *(const f32x4*)(bwb + c);
#pragma unroll
                for (int ai = 0; ai < 2; ++ai)
#pragma unroll
                    for (int m = 0; m < 4; ++m) acc[ai][bj][m][n] = bsv * ir[ai][m]; }
    }
    __device__ __forceinline__ void operator()(const f32x4 (&acc)[2][2][4][2], const pg8::Unit& u, int wr, int wc, int fr, int fq, const Pre& p) const {
        const int row0 = u.pm * 256 + wr * 64 + fr, ch0 = u.pn * 128 + wc * 32 + 8 * fq;
#pragma unroll
        for (int ai = 0; ai < 2; ++ai)
#pragma unroll
            for (int m = 0; m < 4; ++m) { const int row = row0 + ai * 128 + m * 16; const float rs = rstd_of(p.ssv[ai][m]);
                f32x4 a0 = acc[ai][0][m][0] * rs, a1 = acc[ai][0][m][1] * rs, g0 = acc[ai][1][m][0] * rs, g1 = acc[ai][1][m][1] * rs;
#pragma unroll
                for (int e = 0; e < 4; ++e) { a0[e] *= sigm(g0[e]); a1[e] *= sigm(g1[e]); }
                u32x4 w; w.x = pk2(a0[0], a0[1]); w.y = pk2(a0[2], a0[3]); w.z = pk2(a1[0], a1[1]); w.w = pk2(a1[2], a1[3]);
                *(u32x4*)(O + (size_t)row * 1024 + ch0) = w; }
    }
};
struct EpiFF1 {
    static constexpr bool PERM = true, AFTER_DRAIN = false, ACC_INIT = true;
    bf16* O; const float* ss; const float* bw;
    struct Pre { float ssv[2][4]; };
    __device__ __forceinline__ void preload(Pre& p, const pg8::Unit& u, int wr, int wc, int fr, int fq) const {
        const int row0 = u.pm * 256 + wr * 64 + fr;
#pragma unroll
        for (int ai = 0; ai < 2; ++ai)
#pragma unroll
            for (int m = 0; m < 4; ++m) p.ssv[ai][m] = ss_row(ss, row0 + ai * 128 + m * 16);
    }
    __device__ __forceinline__ void init_acc(f32x4 (&acc)[2][2][4][2], const pg8::Unit& u, int wr, int wc, int fr, int fq, const Pre& p) const {
        const int col0 = u.pn * 256 + wc * 32 + 8 * fq, bi = u.pm < (ML / 256) ? u.pm / (SEQ / 256) : 4;
        float ir[2][4];
#pragma unroll
        for (int ai = 0; ai < 2; ++ai)
#pragma unroll
            for (int m = 0; m < 4; ++m) ir[ai][m] = __builtin_amdgcn_sqrtf(p.ssv[ai][m] * (1.0f / 1024.0f) + 1e-6f);
#pragma unroll
        for (int bj = 0; bj < 2; ++bj)
#pragma unroll
            for (int n = 0; n < 2; ++n) { const f32x4 bsv = *(const f32x4*)(bw + bi * 4096 + col0 + bj * 128 + 4 * n);
#pragma unroll
                for (int ai = 0; ai < 2; ++ai)
#pragma unroll
                    for (int m = 0; m < 4; ++m) acc[ai][bj][m][n] = bsv * ir[ai][m]; }
    }
    __device__ __forceinline__ void operator()(const f32x4 (&acc)[2][2][4][2], const pg8::Unit& u, int wr, int wc, int fr, int fq, const Pre& p) const {
        const int row0 = u.pm * 256 + wr * 64 + fr, col0 = u.pn * 256 + wc * 32 + 8 * fq;
#pragma unroll
        for (int ai = 0; ai < 2; ++ai)
#pragma unroll
            for (int m = 0; m < 4; ++m) { const int row = row0 + ai * 128 + m * 16; const float rs = rstd_of(p.ssv[ai][m]); bf16* rowp = O + (size_t)row * FF + col0;
#pragma unroll
                for (int bj = 0; bj < 2; ++bj) { f32x4 v0 = acc[ai][bj][m][0] * rs, v1 = acc[ai][bj][m][1] * rs;
#pragma unroll
                    for (int e = 0; e < 4; ++e) { const float r0 = fmaxf(v0[e], 0.f), r1 = fmaxf(v1[e], 0.f); v0[e] = r0 * r0; v1[e] = r1 * r1; }
                    u32x4 w; w.x = pk2(v0[0], v0[1]); w.y = pk2(v0[2], v0[3]); w.z = pk2(v1[0], v1[1]); w.w = pk2(v1[2], v1[3]);
                    *(u32x4*)(rowp + bj * 128) = w; } }
    }
};
template <bool BIAS, bool LAST> struct EpiRes {
    static constexpr bool PERM = true, AFTER_DRAIN = false, ACC_INIT = BIAS;
    struct Pre {}; __device__ __forceinline__ void preload(Pre&, const pg8::Unit&, int, int, int, int) const {}
    __device__ __forceinline__ void init_acc(f32x4 (&acc)[2][2][4][2], const pg8::Unit& u, int, int wc, int, int fq, const Pre&) const {
        if (u.kt0 != 0) return;
        const int col0 = u.pn * 256 + wc * 32 + 8 * fq;
#pragma unroll
        for (int bj = 0; bj < 2; ++bj)
#pragma unroll
            for (int n = 0; n < 2; ++n) { const f32x4 bsv = *(const f32x4*)(bias + col0 + bj * 128 + 4 * n);
#pragma unroll
                for (int ai = 0; ai < 2; ++ai)
#pragma unroll
                    for (int m = 0; m < 4; ++m) acc[ai][bj][m][n] = bsv; }
    }
    bf16* HX; const float* gp; const float* scp  ; const float* gn; const float* scn  ;
    const float* gate  ; const float* bias; float* part; float* SSn  ; float* outf; float* lsq  ;
    __device__ __forceinline__ void operator()(const f32x4 (&acc)[2][2][4][2], const pg8::Unit& u, int wr, int wc, int fr, int fq, const Pre&) const {
        const int row0 = u.pm * 256 + wr * 64 + fr, col0 = u.pn * 256 + wc * 32 + 8 * fq;
        const int bi = u.pm < (ML / 256) ? u.pm / (SEQ / 256) : 4;
        if (u.kind == 2) {
#pragma unroll
            for (int bj = 0; bj < 2; ++bj)
#pragma unroll
                for (int n = 0; n < 2; ++n) { const int c = col0 + bj * 128 + 4 * n; const f32x4 gt = *(const f32x4*)(gate + (size_t)bi * 6144 + c);
                    #pragma unroll
                    for (int ai = 0; ai < 2; ++ai)
#pragma unroll
                        for (int m = 0; m < 4; ++m) { const int row = row0 + ai * 128 + m * 16;
                            *(f32x4*)(part + ((size_t)(u.kt0 / u.knt) * MC + (row - ML)) * D + c) = gt * acc[ai][bj][m][n]; } }
            return;
        }
        f32x4 gt[2][2], igp[2][2], gm[2][2];
#pragma unroll
        for (int bj = 0; bj < 2; ++bj)
#pragma unroll
            for (int n = 0; n < 2; ++n) { const int c = col0 + bj * 128 + 4 * n; gt[bj][n] = *(const f32x4*)(gate + (size_t)bi * 6144 + c);
                const f32x4 g0 = *(const f32x4*)(gp + c) * (*(const f32x4*)(scp + (size_t)bi * 6144 + c) + 1.0f);
                igp[bj][n] = (f32x4){__builtin_amdgcn_rcpf(g0[0]), __builtin_amdgcn_rcpf(g0[1]), __builtin_amdgcn_rcpf(g0[2]), __builtin_amdgcn_rcpf(g0[3])};
                if (LAST) gm[bj][n] = (f32x4){1.f, 1.f, 1.f, 1.f}; else gm[bj][n] = *(const f32x4*)(gn + c) * (*(const f32x4*)(scn + (size_t)bi * 6144 + c) + 1.0f); }
        u32x4 rbuf[1][2];
#define ERES_LOAD(slot, idx) do { const bf16* rp_ = HX + (size_t)(row0 + ((idx) >> 2) * 128 + ((idx) & 3) * 16) * D + col0; rbuf[slot][0] = *(const u32x4*)rp_; rbuf[slot][1] = *(const u32x4*)(rp_ + 128); } while (0)
        ERES_LOAD(0, 0);
#pragma unroll
        for (int idx = 0; idx < 8; ++idx) { const int ai = idx >> 2, m = idx & 3, row = row0 + ai * 128 + m * 16; float sq = 0.f;
            if (idx > 0) ERES_LOAD(0, idx);
#pragma unroll
            for (int bj = 0; bj < 2; ++bj) { const u32x4 w = rbuf[0][bj]; const int c = col0 + bj * 128;
                const f32x4 xn0 = (f32x4){bflo(w.x), bfhi(w.x), bflo(w.y), bfhi(w.y)} * igp[bj][0] + gt[bj][0] * acc[ai][bj][m][0];
                const f32x4 xn1 = (f32x4){bflo(w.z), bfhi(w.z), bflo(w.w), bfhi(w.w)} * igp[bj][1] + gt[bj][1] * acc[ai][bj][m][1];
                sq += (xn0[0] * xn0[0] + xn0[1] * xn0[1]) + (xn0[2] * xn0[2] + xn0[3] * xn0[3]) + (xn1[0] * xn1[0] + xn1[1] * xn1[1]) + (xn1[2] * xn1[2] + xn1[3] * xn1[3]);
                { const f32x4 y0 = xn0 * gm[bj][0], y1 = xn1 * gm[bj][1];
                    u32x4 o; o.x = pk2(y0[0], y0[1]); o.y = pk2(y0[2], y0[3]); o.z = pk2(y1[0], y1[1]); o.w = pk2(y1[2], y1[3]);
                    *(u32x4*)(HX + (size_t)row * D + c) = o; } }
            sq += __shfl_xor(sq, 16); sq += __shfl_xor(sq, 32);
            if (fq == 0) lsq[(ai * 128 + wr * 64 + m * 16 + fr) * 4 + wc] = sq; }
#undef ERES_LOAD
        asm volatile("s_waitcnt lgkmcnt(0)" ::: "memory"); __builtin_amdgcn_s_barrier(); asm volatile("" ::: "memory");
        { const int t = wr * 256 + wc * 64 + fq * 16 + fr;
          if (t < 256) { const f32x4 p4 = *(const f32x4*)(lsq + t * 4); SSn[(size_t)(u.pm * 256 + t) * 4 + u.pn] = (p4[0] + p4[1]) + (p4[2] + p4[3]); } }
    }
};

__device__ __forceinline__ void transpose_item(const float* W, int K, int N, bf16* WT, bool pw1perm, float* scr, int item, int lane) {
    const int nblk = N / 32, kb = item / nblk, nb = item % nblk, k0 = 64 * kb, n0 = 32 * nb;
    int nbase = n0;
    if (pw1perm) { nbase = (n0 < 1024) ? 256 * (n0 / 128) + (n0 % 128) : 256 * ((n0 - 1024) / 128) + 128 + ((n0 - 1024) % 128); }
#pragma unroll 8
    for (int i = 0; i < 32; ++i) { const int kk = 2 * i + (lane >> 5); scr[kk * 33 + (lane & 31)] = W[(size_t)(k0 + kk) * N + n0 + (lane & 31)]; }
    __builtin_amdgcn_s_waitcnt(0xc07f); asm volatile("s_waitcnt lgkmcnt(0)" ::: "memory");
    const int c = lane & 7;
#pragma unroll
    for (int j = 0; j < 4; ++j) { const int n = (lane >> 3) + 8 * j; const float* s = scr + (8 * c) * 33 + n;
        u32x4 o; o.x = pk2(s[0 * 33], s[1 * 33]); o.y = pk2(s[2 * 33], s[3 * 33]); o.z = pk2(s[4 * 33], s[5 * 33]); o.w = pk2(s[6 * 33], s[7 * 33]);
        *(u32x4*)(WT + (size_t)(nbase + n) * K + k0 + 8 * c) = o; }
    asm volatile("s_waitcnt lgkmcnt(0)" ::: "memory");
}

__device__ __forceinline__ void gemv5_item(const float* vec, float* red, const float* W, int ldw, int n0, float* out, int ostride, const float* addb, int tid) {
    const int cq = tid & 15, ks = tid >> 4;
    const float* Wp = W + n0 + 4 * cq;
    f32x4 acc[5];
#pragma unroll
    for (int r = 0; r < 5; ++r) acc[r] = (f32x4){0.f, 0.f, 0.f, 0.f};
#pragma unroll 4
    for (int kk = 0; kk < 32; ++kk) { const int k = ks * 32 + kk; const f32x4 w = *(const f32x4*)(Wp + (size_t)k * ldw);
#pragma unroll
        for (int r = 0; r < 5; ++r) acc[r] += w * vec[r * 1024 + k]; }
#pragma unroll
    for (int r = 0; r < 5; ++r) *(f32x4*)(red + (ks * 5 + r) * 64 + 4 * cq) = acc[r];
    __syncthreads();
    if (tid < 320) { const int r = tid >> 6, n = tid & 63; float s = 0.f;
        for (int k2 = 0; k2 < 32; ++k2) s += red[(k2 * 5 + r) * 64 + n];
        out[(size_t)r * ostride + n0 + n] = s + (addb ? addb[n0 + n] : 0.f); }
    __syncthreads();
}
__device__ __forceinline__ void p0a_phase(int G, const float* const* in, unsigned char* ws, unsigned char* lds) {
    const int tid = pg8::tid_opaque();
    float* sl = (float*)(lds + 72 * 1024);
    float* red = (float*)(lds + 92 * 1024);
    const float* cin = in[1]; const float* cctx = in[3];
    float* MOD = (float*)(ws + WS_MOD);
    for (int e = tid; e < 5 * 1024; e += NTHR) { const int r = e >> 10, k = e & 1023; const float v = r < 4 ? cin[r * 1024 + k] : cctx[k]; sl[e] = v * sigm(v); }
    __syncthreads();
    for (int item = blockIdx.x; item < 4 * 96; item += G) { const int l = item / 96, n0 = (item % 96) * 64;
        gemv5_item(sl, red, in[4] + (size_t)l * 1024 * 6144, 6144, n0, MOD + (size_t)l * 5 * 6144, 6144, in[5] + l * 6144, tid); }
}
__device__ __forceinline__ void prep_rows(int G, int row_lo, int row_hi, const float* src_lat, const float* src_ctx, const float* part, int nparts, float* Xctx,
                                          const float* g, const float* sc  , bf16* XB, float* SS) {
    const int tid = pg8::tid_opaque(), lane = tid & 63, gw = blockIdx.x * 8 + (tid >> 6), NGW = G * 8;
    for (int row = row_lo + gw; row < row_hi; row += NGW) {
        const float* xr = row < ML ? src_lat + (size_t)row * D : src_ctx + (size_t)(row - ML) * D;
        const int bi = row < ML ? row / SEQ : 4;
        f32x4 v[4]; float ss = 0.f;
#pragma unroll
        for (int j = 0; j < 4; ++j) v[j] = *(const f32x4*)(xr + 256 * j + 4 * lane);
        if (row >= ML && nparts > 0) {
#pragma unroll 1
            for (int p = 0; p < nparts; ++p) { const float* pr = part + ((size_t)p * MC + (row - ML)) * D;
#pragma unroll
                for (int j = 0; j < 4; ++j) v[j] += *(const f32x4*)(pr + 256 * j + 4 * lane); }
#pragma unroll
            for (int j = 0; j < 4; ++j) *(f32x4*)(Xctx + (size_t)(row - ML) * D + 256 * j + 4 * lane) = v[j];
        }
#pragma unroll
        for (int j = 0; j < 4; ++j) ss += (v[j][0] * v[j][0] + v[j][1] * v[j][1]) + (v[j][2] * v[j][2] + v[j][3] * v[j][3]);
        ss = wave_sum(ss);
        if (lane == 0) *(f32x4*)(SS + (size_t)row * 4) = (f32x4){ss, 0.f, 0.f, 0.f};
        const float* scb = sc + (size_t)bi * 6144;
#pragma unroll
        for (int j = 0; j < 4; ++j) { const int c = 256 * j + 4 * lane;
            const f32x4 y = v[j] * *(const f32x4*)(g + c) * (*(const f32x4*)(scb + c) + 1.0f);
            u32x2 w; w.x = pk2(y[0], y[1]); w.y = pk2(y[2], y[3]);
            *(u32x2*)(XB + (size_t)row * D + c) = w; }
    }
}
__device__ __forceinline__ void fold_rows(int G, bf16* HX, const float* part, int nparts, const float* gp, const float* scp, const float* gn, const float* scn, float* SS) {
    const int tid = pg8::tid_opaque(), lane = tid & 63, gw = blockIdx.x * 8 + (tid >> 6), NGW = G * 8;
    for (int row = ML + gw; row < MT; row += NGW) {
        f32x4 v[4]; float ss = 0.f;
#pragma unroll
        for (int j = 0; j < 4; ++j) { const int c = 256 * j + 4 * lane; const u32x2 w = *(const u32x2*)(HX + (size_t)row * D + c);
            const f32x4 g0 = *(const f32x4*)(gp + c) * (*(const f32x4*)(scp + (size_t)4 * 6144 + c) + 1.0f);
            v[j] = (f32x4){bflo(w.x) / g0[0], bfhi(w.x) / g0[1], bflo(w.y) / g0[2], bfhi(w.y) / g0[3]}; }
        f32x4 pv[8][4];
#pragma unroll
        for (int p = 0; p < 8; ++p) if (p < nparts) { const float* pr = part + ((size_t)p * MC + (row - ML)) * D;
#pragma unroll
            for (int j = 0; j < 4; ++j) pv[p][j] = *(const f32x4*)(pr + 256 * j + 4 * lane); }
#pragma unroll
        for (int p = 0; p < 8; ++p) if (p < nparts) {
#pragma unroll
            for (int j = 0; j < 4; ++j) v[j] += pv[p][j]; }
#pragma unroll
        for (int j = 0; j < 4; ++j) ss += (v[j][0] * v[j][0] + v[j][1] * v[j][1]) + (v[j][2] * v[j][2] + v[j][3] * v[j][3]);
        ss = wave_sum(ss);
        if (lane == 0) *(f32x4*)(SS + (size_t)row * 4) = (f32x4){ss, 0.f, 0.f, 0.f};
#pragma unroll
        for (int j = 0; j < 4; ++j) { const int c = 256 * j + 4 * lane;
            const f32x4 y = v[j] * *(const f32x4*)(gn + c) * (*(const f32x4*)(scn + (size_t)4 * 6144 + c) + 1.0f);
            u32x2 w; w.x = pk2(y[0], y[1]); w.y = pk2(y[2], y[3]);
            *(u32x2*)(HX + (size_t)row * D + c) = w; }
    }
}
__device__ __forceinline__ void p0b_phase(int G, const float* const* in, unsigned char* ws, unsigned char* lds) {
    const int tid = pg8::tid_opaque(), lane = tid & 63, wave = tid >> 6;
    float* sl = (float*)(lds + 72 * 1024);
    float* red = (float*)(lds + 92 * 1024);
    const float* MOD = (const float*)(ws + WS_MOD); float* BIASW = (float*)(ws + WS_BIASW);
    for (int item = blockIdx.x; item < 400; item += G) {
        int s, nb;
        if (item < 40) { s = 0; nb = item; } else if (item < 104) { s = 1; nb = item - 40; } else if (item < 136) { s = 2; nb = item - 104; } else if (item < 200) { s = 3; nb = item - 136; }
        else if (item < 240) { s = 4; nb = item - 200; } else if (item < 304) { s = 5; nb = item - 240; } else if (item < 336) { s = 6; nb = item - 304; } else { s = 7; nb = item - 336; }
        const int l = s >> 1; const float* W; int ldw;
        if (s & 1) { W = in[21] + (size_t)l * D * FF; ldw = FF; } else if ((l & 1) == 0) { W = in[7] + (size_t)(l >> 1) * D * 2560; ldw = 2560; } else { W = in[13] + (size_t)(l >> 1) * D * 2048; ldw = 2048; }
        const float* shp = MOD + (size_t)l * 5 * 6144 + ((s & 1) ? 3072 : 0);
        for (int e = tid; e < 5 * 1024; e += NTHR) sl[e] = shp[(size_t)(e >> 10) * 6144 + (e & 1023)];
        __syncthreads();
        gemv5_item(sl, red, W, ldw, nb * 64, BIASW + (size_t)s * 5 * 4096, 4096, nullptr, tid);
    }
    float* scr = (float*)(lds + wave * 8704);
    const int gw = blockIdx.x * 8 + wave, NGW = G * 8;
    bf16* Win_t = (bf16*)(ws + WS_WIN); bf16* Wout_t = (bf16*)(ws + WS_WOUT); bf16* Wpw1_t = (bf16*)(ws + WS_WPW1); bf16* Wpw2_t = (bf16*)(ws + WS_WPW2);
    bf16* Wff1_t = (bf16*)(ws + WS_WFF1); bf16* Wff2_t = (bf16*)(ws + WS_WFF2);
    constexpr int NITEMS = 8192 + 8192 + 2560 + 1024 + 2048 + 1024;
    for (int it = gw; it < NITEMS; it += NGW) {
        int r = it;
        if (r < 8192) { const int l = r / 2048; transpose_item(in[21] + (size_t)l * D * FF, D, FF, Wff1_t + (size_t)l * FF * D, false, scr, r % 2048, lane); continue; } r -= 8192;
        if (r < 8192) { const int l = r / 2048; transpose_item(in[22] + (size_t)l * FF * D, FF, D, Wff2_t + (size_t)l * D * FF, false, scr, r % 2048, lane); continue; } r -= 8192;
        if (r < 2560) { const int i = r / 1280; transpose_item(in[7] + (size_t)i * D * 2560, D, 2560, Win_t + (size_t)i * 2560 * D, false, scr, r % 1280, lane); continue; } r -= 2560;
        if (r < 1024) { const int i = r / 512; transpose_item(in[8] + (size_t)i * D * D, D, D, Wout_t + (size_t)i * D * D, false, scr, r % 512, lane); continue; } r -= 1024;
        if (r < 2048) { const int i = r / 1024; transpose_item(in[13] + (size_t)i * D * 2048, D, 2048, Wpw1_t + (size_t)i * 2048 * D, true, scr, r % 1024, lane); continue; } r -= 2048;
        { const int i = r / 512; transpose_item(in[19] + (size_t)i * D * D, D, D, Wpw2_t + (size_t)i * D * D, false, scr, r % 512, lane); }
    }
    prep_rows(G, 0, MT, in[0], in[2], nullptr, 0, nullptr, in[6], MOD + 1024, (bf16*)(ws + WS_H), (float*)(ws + WS_SS));
}
__device__ __forceinline__ void final_phase(int G, const bf16* HX, const float* SS, const float* g, float* out) {
    const int tid = pg8::tid_opaque(), lane = tid & 63, gw = blockIdx.x * 8 + (tid >> 6), NGW = G * 8;
    for (int row = gw; row < ML; row += NGW) {
        const bf16* xr = HX + (size_t)row * D; const float rstd = rstd_of(ss_row(SS, row));
#pragma unroll
        for (int j = 0; j < 4; ++j) { const int c = 256 * j + 4 * lane; const u32x2 w = *(const u32x2*)(xr + c);
            *(f32x4*)(out + (size_t)row * D + c) = (f32x4){bflo(w.x), bfhi(w.x), bflo(w.y), bfhi(w.y)} * rstd * *(const f32x4*)(g + c); }
    }
}

__device__ __forceinline__ void gating_phase(int G, int nchunks, const bf16* ZG, bf16* AB, const float* lnv, const float* wsp, const float* bsp, unsigned char* lds) {
    bf16* GT = (bf16*)lds;
    const int tid = pg8::tid_opaque(), q = tid >> 2, c4 = tid & 3, lane = tid & 63, wave = tid >> 6, fr = lane & 15, fq = lane >> 4;
#pragma unroll 1
    for (int item = blockIdx.x; item < nchunks * 4; item += G) {
        const int ch = item >> 2, g = item & 3; const size_t t0 = (size_t)ch * 128;
        const bf16* src = ZG + (t0 + q) * 1024 + 512 + g * 128 + c4 * 32;
        float v[32]; float s = 0.f;
#pragma unroll
        for (int i = 0; i < 4; ++i) { const u32x4 w = *(const u32x4*)(src + 8 * i);
            v[8 * i + 0] = bflo(w.x); v[8 * i + 1] = bfhi(w.x); v[8 * i + 2] = bflo(w.y); v[8 * i + 3] = bfhi(w.y);
            v[8 * i + 4] = bflo(w.z); v[8 * i + 5] = bfhi(w.z); v[8 * i + 6] = bflo(w.w); v[8 * i + 7] = bfhi(w.w); }
#pragma unroll
        for (int e = 0; e < 32; ++e) s += v[e];
        s += __shfl_xor(s, 1); s += __shfl_xor(s, 2);
        const float mean = s * (1.0f / 128.0f); float qq = 0.f;
#pragma unroll
        for (int e = 0; e < 32; ++e) { v[e] -= mean; qq += v[e] * v[e]; }
        qq += __shfl_xor(qq, 1); qq += __shfl_xor(qq, 2);
        const float rstd = __builtin_amdgcn_rsqf(qq * (1.0f / 128.0f) + EPS);
        bf16x8 wf[4];
        { const float* wrow = wsp + (size_t)(g * 128 + 16 * wave + fr) * 128 + 8 * fq;
#pragma unroll
          for (int ks = 0; ks < 4; ++ks) { const f32x4 w0 = *(const f32x4*)(wrow + 32 * ks), w1 = *(const f32x4*)(wrow + 32 * ks + 4);
              u32x4 pw; pw.x = pk2(w0[0], w0[1]); pw.y = pk2(w0[2], w0[3]); pw.z = pk2(w1[0], w1[1]); pw.w = pk2(w1[2], w1[3]); wf[ks] = __builtin_bit_cast(bf16x8, pw); } }
#pragma unroll
        for (int e = 0; e < 32; e += 4) { const f32x4 gv = *(const f32x4*)(lnv + g * 128 + c4 * 32 + e);
#pragma unroll
            for (int k = 0; k < 4; k += 2) { const unsigned pw = pk2(v[e + k] * rstd * gv[k], v[e + k + 1] * rstd * gv[k + 1]);
                GT[(c4 * 32 + e + k) * 136 + q] = (bf16)(pw & 0xffffu); GT[(c4 * 32 + e + k + 1) * 136 + q] = (bf16)(pw >> 16); } }
        const int p = 16 * wave + fr; const float bias = bsp[g * 128 + p];
        const bf16* up = ZG + (t0 + p) * 1024 + g * 128 + 4 * fq; bf16* op = AB + (t0 + p) * 1024 + g * 128 + 4 * fq;
        u32x2 uv[8];
#pragma unroll
        for (int ct = 0; ct < 8; ++ct) uv[ct] = *(const u32x2*)(up + 16 * ct);
        __syncthreads();
        f32x4 sacc[8];
#pragma unroll
        for (int ct = 0; ct < 8; ++ct) { sacc[ct] = (f32x4){0.f, 0.f, 0.f, 0.f};
#pragma unroll
            for (int ks = 0; ks < 4; ++ks) { const bf16x8 gf = *(const bf16x8*)(GT + (16 * ct + fr) * 136 + 32 * ks + 8 * fq);
                sacc[ct] = __builtin_amdgcn_mfma_f32_16x16x32_bf16(gf, wf[ks], sacc[ct], 0, 0, 0); } }
#pragma unroll
        for (int ct = 0; ct < 8; ++ct) { const u32x2 w = uv[ct]; const f32x4 a = sacc[ct] + bias;
            u32x2 o; o.x = pk2(bflo(w.x) * a[0], bfhi(w.x) * a[1]); o.y = pk2(bflo(w.y) * a[2], bfhi(w.y) * a[3]);
            *(u32x2*)(op + 16 * ct) = o; }
        __syncthreads();
    }
}

__device__ __forceinline__ void attn_mfma_phase(int G, bool with_ctx_q, const bf16* Q, const bf16* K, const bf16* VT, bf16* AB, const float* rpb, unsigned char* lds) {
    const int tid = pg8::tid_opaque(), lane = tid & 63, wave = tid >> 6, fr = lane & 15, fq = lane >> 4;
    constexpr float LOG2E = 1.4426950408889634f, SC = 0.125f * LOG2E;
    float* tab = (float*)lds;
    for (int e = tid; e < 8 * 15 * 64; e += NTHR) { const int h = e / 960, rem = e % 960, dr = rem >> 6, x = (rem & 63) - 16; tab[e] = (x >= 0 && x < 31) ? rpb[(h * 15 + dr) * 31 + x] * LOG2E : 0.f; }
    __syncthreads();
    bf16* Kc = (bf16*)(lds + 32768);
    bf16* Vc = (bf16*)(lds + 69632);
    const int nlat = NB * 8 * 16, ntail = with_ctx_q ? NB * 8 : 0;
    int kit = 0, sub = 0, cur_bh = -1; bool tail = false;
#pragma unroll 1
    for (;;) {
        int item;
        if (!tail) { item = 2 * ((int)blockIdx.x + kit * G) + sub; if (item >= nlat) { tail = true; kit = 0; continue; } if (++sub == 2) { sub = 0; ++kit; } }
        else { const int e2t = (G - 1 - (int)blockIdx.x) + kit * G; if (e2t >= ntail) break; item = nlat + e2t; ++kit; }
        int b, h, qrow[2], rq = 0, kr0 = 0, nrows = 0, c0 = 0, cq = 0; bool loc;
        if (item < nlat) { const int bh = item >> 4, quad = item & 15; h = bh & 7; b = bh >> 3; rq = 4 * quad + 2 * (wave >> 2); const int seg = wave & 3; qrow[0] = b * SEQ + rq * 64 + 16 * seg; qrow[1] = qrow[0] + 64; loc = true;
            kr0 = min(max(rq - 4, 0), 56); nrows = min(max(rq - 3, 0), 56) + 8 - kr0; c0 = seg == 0 ? 0 : (seg == 1 ? 8 : (seg == 2 ? 24 : 32)); cq = 16 * seg + fr; }
        else { const int e2 = item - nlat; h = e2 & 7; b = e2 >> 3; qrow[0] = ML + b * CL + 32 * wave; qrow[1] = qrow[0] + 16; loc = false; }
        if (b * 8 + h != cur_bh) {
            cur_bh = b * 8 + h;
            __syncthreads();
            { const int key = tid >> 1, half = tid & 1; const bf16* src = K + (size_t)(ML + b * CL + key) * 512 + h * 64 + half * 32; bf16* dst = Kc + key * 72 + half * 32;
#pragma unroll
              for (int i = 0; i < 4; ++i) *(u32x4*)(dst + 8 * i) = *(const u32x4*)(src + 8 * i); }
            { const int d = tid >> 3, sg = tid & 7; const bf16* src = VT + (size_t)(h * 64 + d) * MT + ML + b * CL + sg * 32; bf16* dst = Vc + d * 264 + sg * 32;
#pragma unroll
              for (int i = 0; i < 4; ++i) *(u32x4*)(dst + 8 * i) = *(const u32x4*)(src + 8 * i); }
            __syncthreads();
        }
        const int cs = min(max(cq - 8, 0), 48), vlo = cs - c0 - 8 * fq, tb = h * 960 + c0 + 8 * fq - cq + 31;
        float cm[8];
#pragma unroll
        for (int i = 0; i < 8; ++i) { const int rel = i - vlo; cm[i] = (rel >= 0 && rel < 16) ? 0.f : -1e30f; }
        bf16x8 qf[2][2];
#pragma unroll
        for (int x = 0; x < 2; ++x)
#pragma unroll
            for (int ds = 0; ds < 2; ++ds) qf[x][ds] = *(const bf16x8*)(Q + (size_t)(qrow[x] + fr) * 512 + h * 64 + 32 * ds + 8 * fq);
        f32x4 oacc[2][4];
#pragma unroll
        for (int x = 0; x < 2; ++x)
#pragma unroll
            for (int dt = 0; dt < 4; ++dt) oacc[x][dt] = (f32x4){0.f, 0.f, 0.f, 0.f};
        float m[2] = {-1e30f, -1e30f}, lsum[2] = {0.f, 0.f};
        const bf16* Kh = K + h * 64 + 8 * fq + (size_t)(8 * (fr >> 2) + (fr & 3)) * 512;
        const bf16* Vh = VT + (size_t)(h * 64 + fr) * MT + 8 * fq;
        bf16x8 kfr[2][2][2];
#define ATT_LOADK(ch_) do { const int np_ = ((ch_) == 4) ? 1 : 2; \
            _Pragma("unroll") for (int p = 0; p < 2; ++p) if (p < np_) { \
                _Pragma("unroll") for (int T = 0; T < 2; ++T) { \
                    if ((ch_) < 5) { const bf16* kp = Kh + ((size_t)b * SEQ + (kr0 + 2 * (ch_) + p) * 64 + c0 + 4 * T) * 512; kfr[p][T][0] = *(const bf16x8*)kp; kfr[p][T][1] = *(const bf16x8*)(kp + 32); } \
                    else { const bf16* kl = Kc + (((ch_) - 5) * 64 + 32 * p + 4 * T + 8 * (fr >> 2) + (fr & 3)) * 72 + 8 * fq; kfr[p][T][0] = *(const bf16x8*)kl; kfr[p][T][1] = *(const bf16x8*)(kl + 32); } } } } while (0)
        int ch = loc ? 0 : 5;
        ATT_LOADK(ch);
#pragma unroll 1
        while (ch < 9) {
            int nch = ch + 1; if (nch == 4 && nrows < 9) nch = 5;
            const bool lch = ch < 5; const int np = (ch == 4) ? 1 : 2;
            bf16x8 vfr[2][4];
#pragma unroll
            for (int p = 0; p < 2; ++p) if (p < np) {
                const size_t kb = (size_t)b * SEQ + (kr0 + 2 * ch + p) * 64 + c0;
#pragma unroll
                for (int dt = 0; dt < 4; ++dt) vfr[p][dt] = lch ? *(const bf16x8*)(Vh + (size_t)(16 * dt) * MT + kb) : *(const bf16x8*)(Vc + (16 * dt + fr) * 264 + (ch - 5) * 64 + 32 * p + 8 * fq);
            }
            f32x4 sv[2][4];
#pragma unroll
            for (int p = 0; p < 2; ++p) {
                if (p < np) {
#pragma unroll
                    for (int T = 0; T < 2; ++T)
#pragma unroll
                        for (int x = 0; x < 2; ++x) { f32x4 acc = (f32x4){0.f, 0.f, 0.f, 0.f};
                            acc = __builtin_amdgcn_mfma_f32_16x16x32_bf16(kfr[p][T][0], qf[x][0], acc, 0, 0, 0);
                            acc = __builtin_amdgcn_mfma_f32_16x16x32_bf16(kfr[p][T][1], qf[x][1], acc, 0, 0, 0);
                            sv[x][2 * p + T] = acc; }
                } else {
#pragma unroll
                    for (int x = 0; x < 2; ++x) { sv[x][2 * p] = (f32x4){-1e30f, -1e30f, -1e30f, -1e30f}; sv[x][2 * p + 1] = (f32x4){-1e30f, -1e30f, -1e30f, -1e30f}; }
                }
            }
            if (nch < 9) ATT_LOADK(nch);
            if (lch) {
#pragma unroll
                for (int x = 0; x < 2; ++x)
#pragma unroll
                    for (int p = 0; p < 2; ++p) if (p < np) { const int kr = kr0 + 2 * ch + p, rx = rq + x, w0 = min(max(rx - 4, 0), 56);
                        const bool rowok = kr >= w0 && kr < w0 + 8; const float* tp = tab + tb + min(max(kr - rx + 7, 0), 14) * 64;
#pragma unroll
                        for (int T = 0; T < 2; ++T)
#pragma unroll
                            for (int r = 0; r < 4; ++r) sv[x][2 * p + T][r] = rowok ? sv[x][2 * p + T][r] * SC + (tp[4 * T + r] + cm[4 * T + r]) : -1e30f; }
            } else {
#pragma unroll
                for (int x = 0; x < 2; ++x)
#pragma unroll
                    for (int t = 0; t < 4; ++t) sv[x][t] = sv[x][t] * SC;
            }
            bf16x8 pf[2][2];
#pragma unroll
            for (int x = 0; x < 2; ++x) {
                float mx = -1e30f;
#pragma unroll
                for (int t = 0; t < 4; ++t) mx = fmaxf(mx, fmaxf(fmaxf(sv[x][t][0], sv[x][t][1]), fmaxf(sv[x][t][2], sv[x][t][3])));
                mx = fmaxf(mx, __shfl_xor(mx, 16)); mx = fmaxf(mx, __shfl_xor(mx, 32));
                const float mn = fmaxf(m[x], mx), corr = __builtin_amdgcn_exp2f(m[x] - mn); m[x] = mn;
                float ps = 0.f;
#pragma unroll
                for (int t = 0; t < 4; ++t)
#pragma unroll
                    for (int r = 0; r < 4; ++r) { const float pv = __builtin_amdgcn_exp2f(sv[x][t][r] - mn); sv[x][t][r] = pv; ps += pv; }
                lsum[x] = lsum[x] * corr + ps;
#pragma unroll
                for (int dt = 0; dt < 4; ++dt) oacc[x][dt] = oacc[x][dt] * corr;
#pragma unroll
                for (int p = 0; p < 2; ++p) { u32x4 pw; pw.x = pk2(sv[x][2 * p][0], sv[x][2 * p][1]); pw.y = pk2(sv[x][2 * p][2], sv[x][2 * p][3]); pw.z = pk2(sv[x][2 * p + 1][0], sv[x][2 * p + 1][1]); pw.w = pk2(sv[x][2 * p + 1][2], sv[x][2 * p + 1][3]);
                    pf[x][p] = __builtin_bit_cast(bf16x8, pw); }
            }
#pragma unroll
            for (int p = 0; p < 2; ++p) if (p < np) {
#pragma unroll
                for (int dt = 0; dt < 4; ++dt)
#pragma unroll
                    for (int x = 0; x < 2; ++x) oacc[x][dt] = __builtin_amdgcn_mfma_f32_16x16x32_bf16(vfr[p][dt], pf[x][p], oacc[x][dt], 0, 0, 0);
            }
            ch = nch;
        }
#undef ATT_LOADK
#pragma unroll
        for (int x = 0; x < 2; ++x) {
            float ls = lsum[x]; ls += __shfl_xor(ls, 16); ls += __shfl_xor(ls, 32);
            const float inv = __builtin_amdgcn_rcpf(ls);
            bf16* op = AB + (size_t)(qrow[x] + fr) * 1024 + 512 + h * 64 + 4 * fq;
#pragma unroll
            for (int dt = 0; dt < 4; ++dt) { u32x2 w; w.x = pk2(oacc[x][dt][0] * inv, oacc[x][dt][1] * inv); w.y = pk2(oacc[x][dt][2] * inv, oacc[x][dt][3] * inv); *(u32x2*)(op + 16 * dt) = w; }
        }
    }
}

__device__ __forceinline__ float dpp_add(float v, const int ctrl_sel) {
    int r;
    if (ctrl_sel == 0) r = __builtin_amdgcn_update_dpp(0, __builtin_bit_cast(int, v), 0xB1, 0xF, 0xF, true);
    else if (ctrl_sel == 1) r = __builtin_amdgcn_update_dpp(0, __builtin_bit_cast(int, v), 0x4E, 0xF, 0xF, true);
    else if (ctrl_sel == 2) r = __builtin_amdgcn_update_dpp(0, __builtin_bit_cast(int, v), 0x141, 0xF, 0xF, true);
    else r = __builtin_amdgcn_update_dpp(0, __builtin_bit_cast(int, v), 0x140, 0xF, 0xF, true);
    return v + __builtin_bit_cast(float, r);
}
__device__ __forceinline__ float row16_sum(float v) { v = dpp_add(v, 0); v = dpp_add(v, 1); v = dpp_add(v, 2); v = dpp_add(v, 3); return v; }
typedef float f32x2 __attribute__((ext_vector_type(2)));
__device__ __forceinline__ void conv_phase(int G, int nrows, const bf16* GLU, bf16* OUT, const float* wdw, const float* bdw, const float* lng, const float* lnb, unsigned char* lds) {
    constexpr int T = 32, NR = T + 30;
    const int tid = pg8::tid_opaque(), lane = tid & 63, wave = tid >> 6, c0 = 2 * tid;
    float* red = (float*)lds;
    f32x2 w[31];
#pragma unroll
    for (int j = 0; j < 31; ++j) w[j] = *(const f32x2*)(wdw + j * 1024 + c0);
    const f32x2 bd = *(const f32x2*)(bdw + c0), gg = *(const f32x2*)(lng + c0), be = *(const f32x2*)(lnb + c0);
#pragma unroll 1
    for (int tile = blockIdx.x; tile < nrows / T; tile += G) {
        const int t0 = tile * T; int lo, hi;
        if (t0 < ML) { lo = (t0 / SEQ) * SEQ; hi = lo + SEQ; } else { lo = ML + ((t0 - ML) / CL) * CL; hi = lo + CL; }
#define CONV_ROW(dst, rr_) do { const int t = t0 - 15 + (rr_), tc = min(max(t, lo), hi - 1); \
            unsigned msk = (t >= lo && t < hi) ? 0xffffffffu : 0u; asm volatile("" : "+v"(msk));     \
            dst = *(const unsigned*)(GLU + (size_t)tc * D + c0) & msk; } while (0)
        unsigned xa[46], xb[16];
#pragma unroll
        for (int rr = 0; rr < 46; ++rr) CONV_ROW(xa[rr], rr);
        f32x2 acc[T];
#pragma unroll
        for (int t = 0; t < T; ++t) acc[t] = bd;
#pragma unroll
        for (int rr = 0; rr < 46; ++rr) { const f32x2 v = (f32x2){bflo(xa[rr]), bfhi(xa[rr])};
            if (rr < 16) CONV_ROW(xb[rr], 46 + rr);
#pragma unroll
            for (int tt = 0; tt < 16; ++tt) { const int j = rr - tt; if (j >= 0 && j < 31) acc[tt] += w[j] * v; } }
#pragma unroll
        for (int rr = 0; rr < 46; ++rr) { const unsigned xr = (rr < 30) ? xa[16 + rr] : xb[rr - 30]; const f32x2 v = (f32x2){bflo(xr), bfhi(xr)};
#pragma unroll
            for (int tt = 0; tt < 16; ++tt) { const int j = rr - tt; if (j >= 0 && j < 31) acc[16 + tt] += w[j] * v; } }
#undef CONV_ROW
#pragma unroll
        for (int tt = 0; tt < T; ++tt) {
            const float s = row16_sum(acc[tt][0] + acc[tt][1]), qq = row16_sum(acc[tt][0] * acc[tt][0] + acc[tt][1] * acc[tt][1]);
            if ((lane & 15) == 0) { red[(wave * 4 + (lane >> 4)) * (2 * T) + tt] = s; red[(wave * 4 + (lane >> 4)) * (2 * T) + T + tt] = qq; } }
        __syncthreads();
        if (tid < T) { float s = 0.f, q = 0.f;
#pragma unroll
            for (int k = 0; k < 32; ++k) { s += red[k * (2 * T) + tid]; q += red[k * (2 * T) + T + tid]; }
            const float mean = s * (1.0f / D), var = fmaxf(q * (1.0f / D) - mean * mean, 0.f);
            red[32 * 2 * T + 2 * tid] = mean; red[32 * 2 * T + 2 * tid + 1] = __builtin_amdgcn_rsqf(var + EPS); }
        __syncthreads();
#pragma unroll
        for (int tt = 0; tt < T; ++tt) { const f32x2 mr = *(const f32x2*)(red + 32 * 2 * T + 2 * tt); const float mean = mr[0], rstd = mr[1];
            const f32x2 z = (acc[tt] - mean) * rstd * gg + be;
            *(unsigned*)(OUT + (size_t)(t0 + tt) * D + c0) = pk2(z[0] * sigm(z[0]), z[1] * sigm(z[1])); }
        __syncthreads();
    }
}

#define LAS __attribute__((address_space(3)))
#define XB_TMO      128
#define XB_XCNT(j)  (256  + 64 * (j))
#define XB_XSUB(j)  (1280 + 64 * (j))
#define XB_XGEN(j)  (2304 + 64 * (j))
#define XB_TOP      3328
#define XB_TOPGEN   3392
#define XCD_BAR_WORDS 3456
#define XB_SPIN_CAP (1u << 18)

__device__ __forceinline__ unsigned xb_ld(unsigned* p)              { return __hip_atomic_load(p, __ATOMIC_RELAXED, __HIP_MEMORY_SCOPE_AGENT); }
__device__ __forceinline__ unsigned xb_add(unsigned* p, unsigned v) { return __hip_atomic_fetch_add(p, v, __ATOMIC_RELAXED, __HIP_MEMORY_SCOPE_AGENT); }
__device__ __forceinline__ unsigned xb_xcc_id() { return (unsigned)__builtin_amdgcn_s_getreg((3 << 11) | 20) & 0xFu; }
#define XB_SPIN(cond, bar) do { unsigned _sp = 0; while (cond) { __builtin_amdgcn_s_sleep(1); \
    if ((++_sp & 255u) == 0u) { if (xb_ld(&(bar)[XB_TMO])) break; if (_sp > XB_SPIN_CAP) { atomicAdd(&(bar)[XB_TMO], 1u); break; } } } } while (0)

struct XcdBarrier {
    unsigned* bar; unsigned x;
    volatile LAS unsigned* st;
};

__device__ __forceinline__ XcdBarrier xcd_barrier_post(unsigned* bar, volatile LAS unsigned* st) {
    XcdBarrier b; b.bar = bar; b.x = xb_xcc_id(); b.st = st;
    if (threadIdx.x == 0) (void)xb_add(&bar[XB_XCNT(b.x)], 1u);
    return b;
}
__device__ __forceinline__ void xcd_barrier_complete(unsigned* bar, unsigned x, unsigned& nloc, unsigned& nx) {
    const unsigned G = gridDim.x * gridDim.y * gridDim.z;
    unsigned sum, cnt, mine, sp = 0u;
    for (;;) {
        sum = 0u; cnt = 0u; mine = 0u;
#pragma unroll
        for (unsigned j = 0; j < 16; ++j) { const unsigned c = xb_ld(&bar[XB_XCNT(j)]); sum += c; cnt += (c > 0u) ? 1u : 0u; mine = (j == x) ? c : mine; }
        if (sum == G) break;
        __builtin_amdgcn_s_sleep(1);
        if ((++sp & 255u) == 0u) { if (xb_ld(&bar[XB_TMO])) break; if (sp > XB_SPIN_CAP) { atomicAdd(&bar[XB_TMO], 1u); break; } }
    }
    nloc = mine > 0u ? mine : 1u; nx = cnt > 0u ? cnt : 1u;
}

__device__ __forceinline__ void xcd_barrier(const XcdBarrier& b) {
    asm volatile("s_waitcnt vmcnt(0)" ::: "memory");
    __syncthreads();
    if (threadIdx.x == 0) {
        unsigned* bar = b.bar;
        __builtin_amdgcn_s_waitcnt(0);
        unsigned nloc = b.st[0], nx = b.st[1];
        if (nloc == 0u) { xcd_barrier_complete(bar, b.x, nloc, nx); b.st[0] = nloc; b.st[1] = nx; }
        const unsigned old = xb_add(&bar[XB_XSUB(b.x)], 1u);
        const unsigned gen = old / nloc;
        if (old + 1u == (gen + 1u) * nloc) {
            __builtin_amdgcn_fence(__ATOMIC_RELEASE, "agent");
            asm volatile("s_waitcnt vmcnt(0)" ::: "memory");
            const unsigned og = xb_add(&bar[XB_TOP], 1u);
            const unsigned tg = og / nx;
            if (og + 1u == (tg + 1u) * nx) xb_add(&bar[XB_TOPGEN], 1u);
            else XB_SPIN(xb_ld(&bar[XB_TOPGEN]) == tg, bar);
            __builtin_amdgcn_fence(__ATOMIC_ACQUIRE, "agent");
            xb_add(&bar[XB_XGEN(b.x)], 1u);
            asm volatile("s_waitcnt vmcnt(0)" ::: "memory");
        } else {
            XB_SPIN(xb_ld(&bar[XB_XGEN(b.x)]) == gen, bar);
            __builtin_amdgcn_fence(__ATOMIC_ACQUIRE, "agent");
            asm volatile("s_waitcnt vmcnt(0)" ::: "memory");
        }
    }
    __syncthreads();
}

#define GSYNC() xcd_barrier(xbar)
struct Args { const float* in[24]; float* out; unsigned char* ws; };
__global__ void __launch_bounds__(NTHR, 2) fwd_kernel(Args a) {
    extern __shared__ __attribute__((aligned(16))) unsigned char lds[];
    cg::grid_group grid = cg::this_grid();
    const int G = gridDim.x, bx = blockIdx.x;
    unsigned char* ws = a.ws;
    PG8_LAS unsigned char* ldsl = (PG8_LAS unsigned char*)lds;
    const float* MOD = (const float*)(ws + WS_MOD);
    float* X = (float*)(ws + WS_X); bf16* H = (bf16*)(ws + WS_H);
    bf16* ZG = (bf16*)(ws + WS_R + R_ZG); bf16* Qb = (bf16*)(ws + WS_R + R_Q); bf16* Kb = (bf16*)(ws + WS_R + R_K); bf16* VT = (bf16*)(ws + WS_R + R_VT); bf16* AB = (bf16*)(ws + WS_R + R_AB);
    bf16* Fb = (bf16*)(ws + WS_R); float* PART = (float*)(ws + WS_PART); float* SS = (float*)(ws + WS_SS); const float* BIASW = (const float*)(ws + WS_BIASW);
    const float* x_in = a.in[0]; const float* ctx_in = a.in[2];
    if (threadIdx.x < 16) ((volatile LAS unsigned*)(ldsl + LDS_BYTES - 64))[threadIdx.x] = 0u;
    __syncthreads();

    const XcdBarrier xbar = xcd_barrier_post((unsigned*)ws, (volatile LAS unsigned*)(ldsl + LDS_BYTES - 64));
    if (gridDim.x == 0x7fffffffu) grid.sync();
    p0a_phase(G, a.in, ws, lds);
    GSYNC();
    p0b_phase(G, a.in, ws, lds);
    GSYNC();
#pragma unroll 1
    for (int l = 0; l < DEPTH; ++l) {
        const int i = l >> 1, sA = 2 * l, sB = 2 * l + 1;
        const float* modl = MOD + (size_t)l * 5 * 6144;
        const int M1 = (l <= 2) ? MT : ML;
        const int M2 = (l < 2) ? MT : ML;

        if ((l & 1) == 0) {
            { const bf16* W = (const bf16*)(ws + WS_WIN) + (size_t)i * 2560 * D;
              pg8::Gemm g{H, W, M1, 2048, D, W + (size_t)2048 * D, H}; pg8::StaticOrder S; S.init(M1, 2048, D, G, bx, 512, M1);
              EpiWin E{ZG, Qb, Kb, VT, SS + (size_t)sA * MT * 4, BIASW + (size_t)sA * 5 * 4096};
              pg8::gemm_phase<EpiWin, pg8::StaticOrder, true, true>(ldsl, g, S, E); }
            GSYNC();
            gating_phase(G, (l == 0 ? MT : ML) / 128, ZG, AB, a.in[9] + i * 512, a.in[10] + (size_t)i * 4 * 128 * 128, a.in[11] + i * 512, lds);
            __syncthreads();
            attn_mfma_phase(G, l == 0, Qb, Kb, VT, AB, a.in[12] + (size_t)i * 8 * 15 * 31, lds);
            GSYNC();
            { pg8::Gemm g{AB, (const bf16*)(ws + WS_WOUT) + (size_t)i * D * D, M2, D, D, nullptr, nullptr}; pg8::StaticOrder S; S.init(M2, D, D, G, bx);
              EpiRes<false, false> E{H, a.in[6] + (size_t)sA * D, modl + 1024, a.in[6] + (size_t)sB * D, modl + 4096, modl + 2048, nullptr, nullptr, SS + (size_t)sB * MT * 4, nullptr, (float*)(lds + 131072)};
              pg8::gemm_phase<EpiRes<false, false>, pg8::StaticOrder, true, true>(ldsl, g, S, E); }
        } else {
            { pg8::Gemm g{H, (const bf16*)(ws + WS_WPW1) + (size_t)i * 2048 * D, M2, 2048, D, nullptr, nullptr}; pg8::StaticOrder S; S.init(M2, 2048, D, G, bx);
              EpiGlu E{ZG, a.in[14] + i * 2048, SS + (size_t)sA * MT * 4, BIASW + (size_t)sA * 5 * 4096};
              pg8::gemm_phase<EpiGlu, pg8::StaticOrder, true, true>(ldsl, g, S, E); }
            GSYNC();
            conv_phase(G, M2, ZG, AB, a.in[15] + (size_t)i * 31 * D, a.in[16] + i * D, a.in[17] + i * D, a.in[18] + i * D, lds);
            GSYNC();
            { pg8::Gemm g{AB, (const bf16*)(ws + WS_WPW2) + (size_t)i * D * D, M2, D, D, nullptr, nullptr}; pg8::StaticOrder S; S.init(M2, D, D, G, bx);
              EpiRes<true, false> E{H, a.in[6] + (size_t)sA * D, modl + 1024, a.in[6] + (size_t)sB * D, modl + 4096, modl + 2048, a.in[20] + i * D, nullptr, SS + (size_t)sB * MT * 4, nullptr, (float*)(lds + 131072)};
              pg8::gemm_phase<EpiRes<true, false>, pg8::StaticOrder, true, true>(ldsl, g, S, E); }
        }
        GSYNC();
        { pg8::Gemm g{H, (const bf16*)(ws + WS_WFF1) + (size_t)l * FF * D, M2, FF, D, nullptr, nullptr}; pg8::StaticOrder S; S.init(M2, FF, D, G, bx);
          EpiFF1 E{Fb, SS + (size_t)sB * MT * 4, BIASW + (size_t)sB * 5 * 4096};
          pg8::gemm_phase<EpiFF1, pg8::StaticOrder, true, true>(ldsl, g, S, E); }
        GSYNC();
        { pg8::Gemm g{Fb, (const bf16*)(ws + WS_WFF2) + (size_t)l * D * FF, M2, D, FF, nullptr, nullptr}; pg8::StaticOrder S; S.init(ML, D, FF, G, bx, 0, 0, M2 - ML, 8);
          if (l < 3) { EpiRes<false, false> E{H, a.in[6] + (size_t)sB * D, modl + 4096, a.in[6] + (size_t)(sB + 1) * D, MOD + (size_t)(l + 1) * 5 * 6144 + 1024, modl + 5120, nullptr, PART, SS + (size_t)(sB + 1) * MT * 4, nullptr, (float*)(lds + 131072)};
            pg8::gemm_phase<EpiRes<false, false>, pg8::StaticOrder, true, true>(ldsl, g, S, E); }
          else { EpiRes<false, true> E{H, a.in[6] + (size_t)sB * D, modl + 4096, nullptr, nullptr, modl + 5120, nullptr, PART, SS + (size_t)(sB + 1) * MT * 4, X, (float*)(lds + 131072)};
            pg8::gemm_phase<EpiRes<false, true>, pg8::StaticOrder, true, true>(ldsl, g, S, E); } }

        GSYNC();
        if (l < 2) {
            fold_rows(G, H, PART, 8, a.in[6] + (size_t)sB * D, modl + 4096, a.in[6] + (size_t)(sB + 1) * D, MOD + (size_t)(l + 1) * 5 * 6144 + 1024, SS + (size_t)(sB + 1) * MT * 4);
            GSYNC();
        }
    }
    final_phase(G, H, SS + (size_t)8 * MT * 4, a.in[23], a.out);
}

extern "C" void kernel_launch(void* const* d_in, const int* in_sizes, int n_in, void* d_out, int out_size, void* d_ws, size_t ws_size, hipStream_t stream) {
    static int grid = 0;
    if (grid == 0) {
        int dev = 0, cus = 0, per_cu = 0;
        if (n_in != 24 || ws_size < WS_END) { fprintf(stderr, "kernel_launch: unexpected n_in %d / ws %zu\n", n_in, ws_size); grid = -1; return; }
        hipGetDevice(&dev); hipDeviceGetAttribute(&cus, hipDeviceAttributeMultiprocessorCount, dev);
        hipFuncSetAttribute((const void*)fwd_kernel, hipFuncAttributeMaxDynamicSharedMemorySize, LDS_BYTES);
        hipOccupancyMaxActiveBlocksPerMultiprocessor(&per_cu, (const void*)fwd_kernel, NTHR, LDS_BYTES);
        if (per_cu < 1 || cus < 1) { fprintf(stderr, "kernel_launch: occupancy %d cus %d\n", per_cu, cus); grid = -1; return; }
        grid = cus * per_cu;
    }
    if (grid < 0) return;
    Args a{};
    for (int i = 0; i < 24; ++i) a.in[i] = (const float*)d_in[i];
    a.out = (float*)d_out; a.ws = (unsigned char*)d_ws;
    if (hipMemsetAsync(d_ws, 0, XCD_BAR_WORDS * sizeof(unsigned), stream) != hipSuccess) { fprintf(stderr, "kernel_launch: memset of the barrier words failed\n"); return; }
    void* args[] = {&a};
    hipError_t e = hipLaunchCooperativeKernel((const void*)fwd_kernel, dim3(grid), dim3(NTHR), args, LDS_BYTES, stream);
    if (e != hipSuccess) fprintf(stderr, "cooperative launch failed: %s (grid %d)\n", hipGetErrorString(e), grid);
}
```
